# Optimizing an MI355X kernel written in HIP

```python
import jax, jax.numpy as jnp
from jax import lax
import numpy as np

D_MODEL = 1024
BATCH = 2
SEQ = 8192
DEPTH = 2

LRU_WIDTH = D_MODEL
LRU_BLOCKS = 16
LRU_BW = LRU_WIDTH // LRU_BLOCKS
CONV_W = 4
LRU_C = 8.0
DIL_PATTERNS = ((128, 1), (512, 4), (2048, 16))
N_GROUPS = 3
HEADS_PER_GROUP = 8
HEAD_DIM = 64
ATT_WIDTH = N_GROUPS * HEADS_PER_GROUP * HEAD_DIM
ATT_OUT = HEADS_PER_GROUP * HEAD_DIM
BAND_BLK = 128
ROPE_THETA = 10000.0
GLA_HEADS = 4
GLA_DK = D_MODEL // 2 // GLA_HEADS
GLA_DV = D_MODEL // GLA_HEADS
GLA_KW = GLA_HEADS * GLA_DK
GLA_VW = GLA_HEADS * GLA_DV
GLA_RANK = 16
GLA_NORMALIZER = 16.0
GLA_CHUNK = 64
N_BRANCH = 3
EPS = 1e-6
IN_SIZES = (LRU_WIDTH, LRU_WIDTH, ATT_WIDTH, ATT_WIDTH, ATT_WIDTH, ATT_OUT,
            GLA_KW, GLA_KW, GLA_VW, GLA_VW, N_BRANCH * D_MODEL)
N_IN = sum(IN_SIZES)

kernel_name = 'hybrid_rglru_dilatedswa_gla_parallel_gated'


def rmsnorm(x, g):
    xf = x.astype(jnp.float32)
    y = xf * lax.rsqrt(jnp.mean(xf * xf, axis=-1, keepdims=True) + EPS)
    return (y * g.astype(jnp.float32)).astype(x.dtype)


def rope(x, pos):
    half = x.shape[-1] // 2
    inv = ROPE_THETA ** (-(jnp.arange(half, dtype=jnp.float32) / half))
    ang = pos.astype(jnp.float32)[:, :, None] * inv
    ang = ang.reshape(ang.shape[:2] + (1,) * (x.ndim - 3) + (half,))
    cos, sin = jnp.cos(ang), jnp.sin(ang)
    xf = x.astype(jnp.float32)
    x1, x2 = xf[..., :half], xf[..., half:]
    return jnp.concatenate([x1 * cos - x2 * sin, x2 * cos + x1 * sin], axis=-1).astype(x.dtype)


def causal_dwconv(x, w, b):
    K = w.shape[0]
    S = x.shape[1]
    xp = jnp.pad(x, ((0, 0), (K - 1, 0), (0, 0)))
    y = b + xp[:, 0:S] * w[0]
    for k in range(1, K):
        y = y + xp[:, k:k + S] * w[k]
    return y


def rg_lru(x, w_a, b_a, w_x, b_x, lam):
    B, S, W = x.shape
    xf = x.astype(jnp.float32)
    xb = xf.reshape(B, S, LRU_BLOCKS, LRU_BW)
    r = jax.nn.sigmoid(jnp.einsum('bsnj,njk->bsnk', xb, w_a.astype(jnp.float32)).reshape(B, S, W) + b_a)
    i = jax.nn.sigmoid(jnp.einsum('bsnj,njk->bsnk', xb, w_x.astype(jnp.float32)).reshape(B, S, W) + b_x)
    log_a = -LRU_C * r * jax.nn.softplus(-lam.astype(jnp.float32))
    a = jnp.exp(log_a)
    u = jnp.sqrt(-jnp.expm1(2.0 * log_a)) * (i * xf)

    def combine(e1, e2):
        a1, b1 = e1
        a2, b2 = e2
        return a1 * a2, a2 * b1 + b2

    _, h = lax.associative_scan(combine, (a, u), axis=1)
    return h.astype(x.dtype)


def dilated_group(q, k, v, window, dil):
    B, S, H, dh = q.shape
    span = window // dil
    unit = dil * BAND_BLK
    pad = (-S) % unit
    L = (S + pad) // dil
    nb = L // BAND_BLK

    def to_blocks(t):
        t = jnp.pad(t, ((0, 0), (0, pad), (0, 0), (0, 0)))
        t = t.reshape(B, L, dil, H, dh).transpose(0, 2, 1, 3, 4)
        return t.reshape(B, dil, nb, BAND_BLK, H, dh)

    def band_keys(t):
        prev = jnp.pad(t, ((0, 0), (0, 0), (1, 0), (0, 0), (0, 0), (0, 0)))[:, :, :-1]
        return jnp.concatenate([prev, t], axis=3)

    qb = to_blocks(q)
    kc = band_keys(to_blocks(k))
    vc = band_keys(to_blocks(v)).astype(jnp.float32)
    s = jnp.einsum('bdnqhe,bdnkhe->bdnhqk', qb, kc, preferred_element_type=jnp.float32)
    qi = jnp.arange(BAND_BLK)[:, None]
    kj = jnp.arange(2 * BAND_BLK)[None, :]
    rel = qi + BAND_BLK - kj
    band = (rel >= 0) & (rel <= span)
    has_prev = (jnp.arange(nb) > 0)[:, None, None] | (kj >= BAND_BLK)[None]
    mask = band[None] & has_prev
    s = jnp.where(mask[:, None], s, -jnp.inf)
    m = jnp.max(s, axis=-1, keepdims=True)
    p = jnp.exp(s - m)
    l = jnp.sum(p, axis=-1, keepdims=True)
    o = jnp.einsum('bdnhqk,bdnkhe->bdnqhe', p / l, vc)
    lse = jnp.swapaxes((m + jnp.log(l))[..., 0], 3, 4)
    o = o.reshape(B, dil, L, H, dh).transpose(0, 2, 1, 3, 4).reshape(B, L * dil, H, dh)[:, :S]
    lse = lse.reshape(B, dil, L, H).transpose(0, 2, 1, 3).reshape(B, L * dil, H)[:, :S]
    return o, lse


def gla_chunked(q, k, v, log_alpha):
    B, S, H, dk = q.shape
    dv = v.shape[-1]
    C = GLA_CHUNK
    n = S // C
    f32 = jnp.float32
    q = q.astype(f32).reshape(B, n, C, H, dk) * (dk ** -0.5)
    k = k.astype(f32).reshape(B, n, C, H, dk)
    v = v.astype(f32).reshape(B, n, C, H, dv)
    b = jnp.cumsum(log_alpha.astype(f32).reshape(B, n, C, H, dk), axis=2)
    b_last = b[:, :, -1:]
    q_dec = q * jnp.exp(b)
    k_inv = k * jnp.exp(-b)
    k_end = k * jnp.exp(b_last - b)
    causal = jnp.tril(jnp.ones((C, C), dtype=bool))
    att = jnp.where(causal, jnp.einsum('bnqhk,bnshk->bnhqs', q_dec, k_inv), 0.0)
    o = jnp.einsum('bnhqs,bnshv->bnqhv', att, v)
    kv = jnp.einsum('bnshk,bnshv->nbhkv', k_end, v)
    decay = jnp.moveaxis(jnp.exp(b_last[:, :, 0]), 1, 0)

    def step(state, inp):
        dec, kv_c = inp
        return dec[..., None] * state + kv_c, state

    _, prev = lax.scan(step, jnp.zeros((B, H, dk, dv), f32), (decay, kv))
    o = o + jnp.einsum('bnqhk,nbhkv->bnqhv', q_dec, prev)
    return o.reshape(B, S, H, dv)


def hybrid_layer(x, c_act, pos, ada_w, ada_b, norm_g, w_in, conv_w, conv_b,
                 lru_wa, lru_ba, lru_wx, lru_bx, lru_lambda, qn_g, kn_g,
                 gla_a1, gla_a2, gla_ab, gla_on_g, proj_a, proj_b, proj_c, w_o):
    B, S, D = x.shape
    mod = c_act @ ada_w + ada_b
    shift, scale, gate = jnp.split(mod, 3, axis=-1)
    h = rmsnorm(x, norm_g) * (1.0 + scale[:, None]) + shift[:, None]
    z = h @ w_in
    (a_x, a_g, b_q, b_k, b_v, b_g, c_q, c_k, c_v, c_g, m_g) = jnp.split(
        z, np.cumsum(IN_SIZES)[:-1].tolist(), axis=-1)

    ya = rg_lru(causal_dwconv(a_x, conv_w, conv_b), lru_wa, lru_ba, lru_wx, lru_bx, lru_lambda)
    ya = ya * jax.nn.silu(a_g)

    shp = (B, S, N_GROUPS, HEADS_PER_GROUP, HEAD_DIM)
    q = rope(rmsnorm(b_q.reshape(shp), qn_g[:, None, :]), pos) * (HEAD_DIM ** -0.5)
    k = rope(rmsnorm(b_k.reshape(shp), kn_g[:, None, :]), pos)
    v = b_v.reshape(shp)
    outs, lses = [], []
    for g, (win, dil) in enumerate(DIL_PATTERNS):
        o_g, lse_g = dilated_group(q[:, :, g], k[:, :, g], v[:, :, g], win, dil)
        outs.append(o_g)
        lses.append(lse_g)
    wts = jax.nn.softmax(jnp.stack(lses, axis=0), axis=0)
    yb = jnp.sum(wts[..., None] * jnp.stack(outs, axis=0), axis=0)
    yb = yb.reshape(B, S, ATT_OUT).astype(x.dtype) * jax.nn.silu(b_g)

    log_alpha = jax.nn.log_sigmoid(((h @ gla_a1) @ gla_a2 + gla_ab).astype(jnp.float32)) / GLA_NORMALIZER
    yc = gla_chunked(c_q.reshape(B, S, GLA_HEADS, GLA_DK), c_k.reshape(B, S, GLA_HEADS, GLA_DK),
                     c_v.reshape(B, S, GLA_HEADS, GLA_DV), log_alpha.reshape(B, S, GLA_HEADS, GLA_DK))
    yc = rmsnorm(yc, gla_on_g).reshape(B, S, GLA_VW).astype(x.dtype) * jax.nn.silu(c_g)

    mg = jax.nn.sigmoid(m_g).reshape(B, S, N_BRANCH, D)
    merged = mg[:, :, 0] * (ya @ proj_a) + mg[:, :, 1] * (yb @ proj_b) + mg[:, :, 2] * (yc @ proj_c)
    return x + gate[:, None] * (merged @ w_o)


def setup_inputs(seed: int = 0) -> dict:
    key = jax.random.key(seed)
    ks = jax.random.split(key, 24)
    D = D_MODEL
    nrm = lambda k, shp, s: jax.random.normal(k, shp, jnp.float32) * s
    x = nrm(ks[0], (BATCH, SEQ, D), 1.0)
    c = nrm(ks[1], (BATCH, D), 1.0)
    positions = (jnp.arange(SEQ, dtype=jnp.int32)[None, :]
                 + jax.random.randint(ks[2], (BATCH, 1), 0, 4096, dtype=jnp.int32))
    ada_w = nrm(ks[3], (DEPTH, D, 3 * D), 0.2 * D ** -0.5)
    ada_b = jnp.concatenate([nrm(ks[4], (DEPTH, 2 * D), 0.02),
                             1.0 + nrm(ks[5], (DEPTH, D), 0.02)], axis=-1)
    norm_g = 1.0 + nrm(ks[6], (DEPTH, D), 0.02)
    w_in = nrm(ks[7], (DEPTH, D, N_IN), D ** -0.5)
    conv_w = nrm(ks[8], (DEPTH, CONV_W, LRU_WIDTH), CONV_W ** -0.5)
    conv_b = nrm(ks[9], (DEPTH, LRU_WIDTH), 0.02)
    lru_wa = nrm(ks[10], (DEPTH, LRU_BLOCKS, LRU_BW, LRU_BW), LRU_BW ** -0.5)
    lru_ba = nrm(ks[11], (DEPTH, LRU_WIDTH), 0.02)
    lru_wx = nrm(ks[12], (DEPTH, LRU_BLOCKS, LRU_BW, LRU_BW), LRU_BW ** -0.5)
    lru_bx = nrm(ks[13], (DEPTH, LRU_WIDTH), 0.02)
    u = jax.random.uniform(ks[14], (DEPTH, LRU_WIDTH), jnp.float32, 0.9, 0.999)
    a0 = u ** (1.0 / LRU_C)
    lru_lambda = jnp.log(a0) - jnp.log1p(-a0)
    qn_g = 1.0 + nrm(ks[15], (DEPTH, N_GROUPS, HEAD_DIM), 0.02)
    kn_g = 1.0 + nrm(ks[16], (DEPTH, N_GROUPS, HEAD_DIM), 0.02)
    gla_a1 = nrm(ks[17], (DEPTH, D, GLA_RANK), D ** -0.5)
    gla_a2 = nrm(ks[18], (DEPTH, GLA_RANK, GLA_KW), GLA_RANK ** -0.5)
    gla_ab = nrm(ks[19], (DEPTH, GLA_KW), 0.02)
    gla_on_g = 1.0 + nrm(ks[20], (DEPTH, GLA_DV), 0.02)
    proj_a = nrm(ks[21], (DEPTH, LRU_WIDTH, D), LRU_WIDTH ** -0.5)
    proj_b = nrm(ks[22], (DEPTH, ATT_OUT, D), ATT_OUT ** -0.5)
    kk = jax.random.split(ks[23], 2)
    proj_c = nrm(kk[0], (DEPTH, GLA_VW, D), GLA_VW ** -0.5)
    w_o = nrm(kk[1], (DEPTH, D, D), D ** -0.5)
    return {'x': x, 'c': c, 'positions': positions, 'ada_w': ada_w, 'ada_b': ada_b,
            'norm_g': norm_g, 'w_in': w_in, 'conv_w': conv_w, 'conv_b': conv_b,
            'lru_wa': lru_wa, 'lru_ba': lru_ba, 'lru_wx': lru_wx, 'lru_bx': lru_bx,
            'lru_lambda': lru_lambda, 'qn_g': qn_g, 'kn_g': kn_g, 'gla_a1': gla_a1,
            'gla_a2': gla_a2, 'gla_ab': gla_ab, 'gla_on_g': gla_on_g, 'proj_a': proj_a,
            'proj_b': proj_b, 'proj_c': proj_c, 'w_o': w_o}


def reference(x, c, positions, ada_w, ada_b, norm_g, w_in, conv_w, conv_b,
              lru_wa, lru_ba, lru_wx, lru_bx, lru_lambda, qn_g, kn_g,
              gla_a1, gla_a2, gla_ab, gla_on_g, proj_a, proj_b, proj_c, w_o):
    c_act = jax.nn.silu(c)
    for l in range(DEPTH):
        x = hybrid_layer(x, c_act, positions, ada_w[l], ada_b[l], norm_g[l], w_in[l],
                         conv_w[l], conv_b[l], lru_wa[l], lru_ba[l], lru_wx[l], lru_bx[l],
                         lru_lambda[l], qn_g[l], kn_g[l], gla_a1[l], gla_a2[l], gla_ab[l],
                         gla_on_g[l], proj_a[l], proj_b[l], proj_c[l], w_o[l])
    return x
```

```cpp
#include <hip/hip_runtime.h>
#include <cstdio>
#include <cstdint>

#ifndef MK_SPLIT
#define MK_SPLIT 1
#endif

#define LAS __attribute__((address_space(3)))
#define GAS __attribute__((address_space(1)))
#define DI __device__ __forceinline__
typedef unsigned short bf16_t;
typedef short bf16x8 __attribute__((ext_vector_type(8)));
typedef short s16x4 __attribute__((ext_vector_type(4)));
typedef float f32x4 __attribute__((ext_vector_type(4)));
typedef float f32x2 __attribute__((ext_vector_type(2)));
typedef float f32x16 __attribute__((ext_vector_type(16)));
typedef unsigned u32x4 __attribute__((ext_vector_type(4)));
typedef unsigned u32x2 __attribute__((ext_vector_type(2)));
typedef __bf16 bf16x2_t __attribute__((ext_vector_type(2)));

constexpr int BATCH = 2, SEQ = 8192, DM = 1024, T = BATCH * SEQ;
constexpr int N_IN = 13312, N_G1A = 7680, N_G1B = 5632;
constexpr float EPS = 1e-6f;
constexpr float LOG2E = 1.4426950408889634f;

__constant__ float c_invf[32] = {
1.000000000e+00f, 7.498942018e-01f, 5.623413324e-01f, 4.216965139e-01f,
3.162277639e-01f, 2.371373773e-01f, 1.778279394e-01f, 1.333521456e-01f,
1.000000015e-01f, 7.498942316e-02f, 5.623413250e-02f, 4.216964915e-02f,
3.162277490e-02f, 2.371373773e-02f, 1.778279431e-02f, 1.333521400e-02f,
9.999999776e-03f, 7.498942316e-03f, 5.623413250e-03f, 4.216964822e-03f,
3.162277630e-03f, 2.371373819e-03f, 1.778279431e-03f, 1.333521446e-03f,
1.000000047e-03f, 7.498941850e-04f, 5.623413017e-04f, 4.216965172e-04f,
3.162277571e-04f, 2.371373703e-04f, 1.778279402e-04f, 1.333521504e-04f};

DI float bf2f(unsigned short u) { return __uint_as_float(((unsigned)u) << 16); }
DI float bflo(unsigned w) { return __uint_as_float(w << 16); }
DI float bfhi(unsigned w) { return __uint_as_float(w & 0xffff0000u); }
DI unsigned pk2(float lo, float hi) { f32x2 v = {lo, hi}; bf16x2_t b = __builtin_convertvector(v, bf16x2_t); return __builtin_bit_cast(unsigned, b); }
DI unsigned short f2bf(float f) { return (unsigned short)(pk2(f, 0.f) & 0xffffu); }
DI float sigmoidf_(float x) { return 1.0f / (1.0f + __expf(-x)); }
DI float siluf_(float x) { return x / (1.0f + __expf(-x)); }
DI int crow(int reg, int h) { return (reg & 3) + 8 * (reg >> 2) + 4 * h; }
#define MFMA32(a, b, c) __builtin_amdgcn_mfma_f32_32x32x16_bf16((a), (b), (c), 0, 0, 0)
DI float wave_sum(float v) {
#pragma unroll
    for (int o = 1; o < 64; o <<= 1) v += __shfl_xor(v, o);
    return v;
}
DI bf16x8 pack_step(const f32x16& x, int s) {
    u32x4 p;
    p[0] = pk2(x[8 * s + 0], x[8 * s + 1]); p[1] = pk2(x[8 * s + 2], x[8 * s + 3]);
    p[2] = pk2(x[8 * s + 4], x[8 * s + 5]); p[3] = pk2(x[8 * s + 6], x[8 * s + 7]);
    return __builtin_bit_cast(bf16x8, p);
}

namespace pg8 {
#define PG8_LAS __attribute__((address_space(3)))
constexpr int BM = 256, BK = 64, HALF = 128, HTB = HALF * BK * 2, STAGE_BYTES = 8 * HTB, NXCD = 8, WGM = 8;
__host__ __device__ __forceinline__ int lds_byte(int r, int c) { const int st = (r >> 4) * 2 + (c >> 5), rr = r & 15, cc = c & 31, ob = rr * 64 + cc * 2; return st * 1024 + (ob ^ (((ob >> 9) & 1) << 5)); }
__host__ __device__ __forceinline__ void stage_rc(int b, int& R, int& C) { const int st = b / 1024, sb = b % 1024, swz = sb ^ (((sb >> 9) & 1) << 5); R = (st >> 1) * 16 + swz / 64; C = (st & 1) * 32 + (swz % 64) / 2; }
__host__ __device__ __forceinline__ int perm32(int rho) { const int n = rho >> 4, i = rho & 15; return 8 * (i >> 2) + 4 * n + (i & 3); }
struct Unit { int pm, pn; };
struct StaticOrder {
    int nM, nN, nwg, G, c;
    __host__ __device__ void init(int M, int N, int G_, int c_) { nM = M / BM; nN = N / BM; nwg = nM * nN; G = G_; c = c_; }
    __host__ __device__ bool next(int i, Unit& u) const {
        const long L = (long)i * G + c; if (L >= nwg) return false;
        int wgid = (int)L; { const int q = nwg / NXCD, r = nwg % NXCD, xcd = wgid % NXCD, off = wgid / NXCD; wgid = (xcd < r ? xcd * (q + 1) : r * (q + 1) + (xcd - r) * q) + off; }
        const int nig = WGM * nN, gid = wgid / nig, fm = gid * WGM, gsz = (nM - fm) < WGM ? (nM - fm) : WGM;
        u.pm = fm + ((wgid % nig) % gsz); u.pn = (wgid % nig) / gsz; return true;
    }
};
struct APlain { const bf16_t* A; int lda;
    DI const char* at(int pm, int t) const { return (const char*)(A + (size_t)pm * 256 * lda + (size_t)t * 64); } };
struct ASeg3 { const bf16_t* A0; const bf16_t* A1; const bf16_t* A2; int lda;
    DI const char* at(int pm, int t) const { const bf16_t* base = t < 16 ? A0 + t * 64 : (t < 24 ? A1 + (t - 16) * 64 : A2 + (t - 24) * 64); return (const char*)(base + (size_t)pm * 256 * lda); } };

template <class Epi, class AP, class Sched>
__device__ __forceinline__ void gemm_phase(PG8_LAS unsigned char* lds, int tid, const AP ap, const bf16_t* Bt, int ldb, int K, const Sched& S, const Epi& E) {
    const int wid = __builtin_amdgcn_readfirstlane(tid >> 6), lane = tid & 63, wr = wid >> 2, wc = wid & 3, fr = lane & 15, fq = lane >> 4;
    const int nt = K / BK, lda = ap.lda;
    unsigned voffA[2], voffB[2];
#pragma unroll
    for (int i = 0; i < 2; ++i) { int R, C; stage_rc(tid * 16 + i * 8192, R, C); const int Rb = Epi::PERM ? ((R & ~31) + perm32(R & 31)) : R;
        voffA[i] = (unsigned)(R * lda + C) * 2u; voffB[i] = (unsigned)(Rb * ldb + C) * 2u; }
    const size_t kstep = (size_t)(BK * 2);
    const size_t hstepA = (size_t)HALF * lda * 2, hstepB = (size_t)HALF * ldb * 2;
    const size_t tstepB = 2 * hstepB;
    const unsigned ldsw = (unsigned)wid * 1024u;
    const int aoff = lds_byte(wr * 64 + fr, fq * 8), boff = lds_byte(wc * 32 + fr, fq * 8);
#define PG8_SA(b, h) (((b) * 2 + (h)) * HTB)
#define PG8_SB(b, h) ((4 + (b) * 2 + (h)) * HTB)
#define PG8_STAGE(bufoff, gbase, voff) do { _Pragma("unroll") for (int _i = 0; _i < 2; ++_i) \
        __builtin_amdgcn_global_load_lds((const unsigned*)((const char*)(gbase) + (voff)[_i]), (PG8_LAS unsigned*)(lds + (bufoff) + ldsw + _i * 8192), 16, 0, 0); } while (0)
#define PG8_LDA(dst, b, h) do { _Pragma("unroll") for (int m = 0; m < 4; ++m) _Pragma("unroll") for (int k = 0; k < 2; ++k) dst[m][k] = *(const PG8_LAS bf16x8*)(lds + PG8_SA(b, h) + aoff + m * 2048 + k * 1024); } while (0)
#define PG8_LDB(dst, b, h) do { _Pragma("unroll") for (int n = 0; n < 2; ++n) _Pragma("unroll") for (int k = 0; k < 2; ++k) dst[n][k] = *(const PG8_LAS bf16x8*)(lds + PG8_SB(b, h) + boff + n * 2048 + k * 1024); } while (0)
#define PG8_MMA(ai, bj, At, Bt_) do { __builtin_amdgcn_s_setprio(1); _Pragma("unroll") for (int m = 0; m < 4; ++m) _Pragma("unroll") for (int n = 0; n < 2; ++n) _Pragma("unroll") for (int k = 0; k < 2; ++k) \
        acc[ai][bj][m][n] = __builtin_amdgcn_mfma_f32_16x16x32_bf16(Bt_[n][k], At[m][k], acc[ai][bj][m][n], 0, 0, 0); __builtin_amdgcn_s_setprio(0); } while (0)
#define PG8_WAIT_V(n) asm volatile("s_waitcnt vmcnt(" #n ")" ::: "memory")
#define PG8_WAIT_L(n) asm volatile("s_waitcnt lgkmcnt(" #n ")" ::: "memory")
#define PG8_BAR __builtin_amdgcn_s_barrier()
#define PG8_SCHED __builtin_amdgcn_sched_barrier(0)
    Unit cur, nxt; int ui = 0;
    if (!S.next(0, cur)) return;
    f32x4 acc[2][2][4][2];
#pragma unroll
    for (int a = 0; a < 2; ++a)
#pragma unroll
        for (int b = 0; b < 2; ++b)
#pragma unroll
            for (int m = 0; m < 4; ++m)
#pragma unroll
                for (int n = 0; n < 2; ++n) acc[a][b][m][n] = (f32x4){0.f, 0.f, 0.f, 0.f};
    bf16x8 At[4][2], B0[2][2], B1[2][2];
    const char* cB = (const char*)Bt + (size_t)cur.pn * tstepB;
    {
        const char* cA0 = ap.at(cur.pm, 0); const char* cA1 = ap.at(cur.pm, 1);
        PG8_STAGE(PG8_SB(0, 0), cB, voffB); PG8_STAGE(PG8_SB(0, 1), cB + hstepB, voffB); PG8_STAGE(PG8_SA(0, 0), cA0, voffA); PG8_STAGE(PG8_SA(0, 1), cA0 + hstepA, voffA);
        if (wr == 1) PG8_BAR;
        PG8_WAIT_V(2); PG8_BAR;
        PG8_STAGE(PG8_SB(1, 0), cB + kstep, voffB); PG8_STAGE(PG8_SA(1, 0), cA1, voffA); PG8_STAGE(PG8_SB(1, 1), cB + hstepB + kstep, voffB);
        PG8_WAIT_V(6); PG8_BAR;
    }
    for (;;) {
        const bool has_next = S.next(ui + 1, nxt);
        const Unit nu = has_next ? nxt : cur;
        const char* nB = (const char*)Bt + (size_t)nu.pn * tstepB;
        for (int t = 0; t < nt; t += 2) {
            const bool last = (t == nt - 2);
            if constexpr (Epi::KHOOK) { E.khook(acc, cur, t, wr, wc, fr, fq); PG8_SCHED; }
            const char* a1 = ap.at(cur.pm, t + 1);
            const char* a2 = last ? ap.at(nu.pm, 0) : ap.at(cur.pm, t + 2);
            const char* a3 = last ? ap.at(nu.pm, 1) : ap.at(cur.pm, t + 3);
            const char* b2 = last ? nB : cB + (size_t)(t + 2) * kstep;
            const char* b3 = b2 + kstep;
            PG8_LDB(B0, 0, 0); PG8_LDB(B1, 0, 1); PG8_SCHED; PG8_LDA(At, 0, 0); PG8_STAGE(PG8_SA(1, 1), a1 + hstepA, voffA);
            PG8_WAIT_V(8); PG8_WAIT_L(0); PG8_BAR; PG8_MMA(0, 0, At, B0); PG8_MMA(0, 1, At, B1); PG8_BAR; PG8_SCHED;
            PG8_LDA(At, 0, 1); PG8_STAGE(PG8_SB(0, 0), b2, voffB); PG8_STAGE(PG8_SB(0, 1), b2 + hstepB, voffB); PG8_STAGE(PG8_SA(0, 0), a2, voffA);
            PG8_WAIT_V(8); PG8_WAIT_L(0); PG8_BAR; PG8_MMA(1, 0, At, B0); PG8_MMA(1, 1, At, B1); PG8_BAR; PG8_SCHED;
            PG8_LDB(B0, 1, 0); PG8_LDB(B1, 1, 1); PG8_SCHED; PG8_LDA(At, 1, 0); PG8_STAGE(PG8_SA(0, 1), a2 + hstepA, voffA);
            PG8_WAIT_V(8); PG8_WAIT_L(0); PG8_BAR; PG8_MMA(0, 0, At, B0); PG8_MMA(0, 1, At, B1); PG8_BAR; PG8_SCHED;
            PG8_LDA(At, 1, 1); PG8_STAGE(PG8_SB(1, 0), b3, voffB); PG8_STAGE(PG8_SB(1, 1), b3 + hstepB, voffB); PG8_STAGE(PG8_SA(1, 0), a3, voffA);
            PG8_WAIT_V(8); PG8_WAIT_L(0); PG8_BAR; PG8_MMA(1, 0, At, B0); PG8_MMA(1, 1, At, B1); PG8_BAR; PG8_SCHED;
        }
        if (wr == 0) PG8_BAR;
        E(acc, cur, wr, wc, fr, fq);
        if (!has_next) break;
#pragma unroll
        for (int a = 0; a < 2; ++a)
#pragma unroll
            for (int b = 0; b < 2; ++b)
#pragma unroll
                for (int m = 0; m < 4; ++m)
#pragma unroll
                    for (int n = 0; n < 2; ++n) acc[a][b][m][n] = (f32x4){0.f, 0.f, 0.f, 0.f};
        cur = nxt; cB = nB; ++ui;
        if (wr == 1) PG8_BAR;
    }
    PG8_WAIT_V(0);
    PG8_BAR;
#undef PG8_SA
#undef PG8_SB
#undef PG8_STAGE
#undef PG8_LDA
#undef PG8_LDB
#undef PG8_MMA
#undef PG8_WAIT_V
#undef PG8_WAIT_L
#undef PG8_BAR
#undef PG8_SCHED
}
}

constexpr size_t MiB = 1u << 20;
constexpr size_t WS_CTL = 0, CTL_ZERO_BYTES = 64 * 1024;
constexpr size_t WS_MODF = 1 * MiB;
constexpr size_t WS_MODP = WS_MODF + 64 * 1024;
constexpr size_t WS_LRUW = 2 * MiB;
constexpr size_t WS_GDEC = WS_LRUW + 256 * 1024;
constexpr size_t WS_LR   = 3 * MiB;
constexpr size_t WS_ROPE = 4 * MiB;
constexpr size_t WS_LSE  = 8 * MiB;
constexpr size_t WS_LA   = 10 * MiB;
constexpr size_t WS_LH   = 11 * MiB;
constexpr size_t WS_LC   = 12 * MiB;
constexpr size_t WS_WO   = 13 * MiB;
constexpr size_t WS_WP   = 15 * MiB;
constexpr size_t WS_WIN  = 20 * MiB;
constexpr size_t WS_H    = 46 * MiB;
constexpr size_t WS_AX   = 78 * MiB;
constexpr size_t WS_Q    = 110 * MiB;
constexpr size_t WS_K    = 158 * MiB;
constexpr size_t WS_VT   = 206 * MiB;
constexpr size_t WS_CQ   = 254 * MiB;
constexpr size_t WS_CK   = 270 * MiB;
constexpr size_t WS_CV   = 286 * MiB;
constexpr size_t WS_YA   = 318 * MiB;
constexpr size_t WS_KV   = 350 * MiB;
constexpr size_t WS_END  = 414 * MiB;
constexpr size_t WS_MG = WS_Q, WS_YB = WS_VT, WS_MERGED = WS_AX, WS_YC = WS_CV;

constexpr int RING_BYTES = 131072, LDSCTL_OFF = RING_BYTES, MISC_OFF = LDSCTL_OFF + 320, LDS_BYTES = 147456;
constexpr int NWAVES = 8, NTHR = 512;

typedef GAS unsigned gu32;
#define RLX_AGENT __ATOMIC_RELAXED, __HIP_MEMORY_SCOPE_AGENT
#define XB_TMO      128
#define XB_XCNT(j)  (256  + 64 * (j))
#define XB_XSUB(j)  (1280 + 64 * (j))
#define XB_XGEN(j)  (2304 + 64 * (j))
#define XB_TOP      3328
#define XB_TOPGEN   3392
#define XCD_BAR_WORDS 3456
#define XB_SPIN_CAP (1u << 18)
DI unsigned xb_ld(unsigned* p)              { return __hip_atomic_load(p, __ATOMIC_RELAXED, __HIP_MEMORY_SCOPE_AGENT); }
DI unsigned xb_add(unsigned* p, unsigned v) { return __hip_atomic_fetch_add(p, v, __ATOMIC_RELAXED, __HIP_MEMORY_SCOPE_AGENT); }
DI unsigned xb_xcc_id() { return (unsigned)__builtin_amdgcn_s_getreg((3 << 11) | 20) & 0xFu; }
#define XB_SPIN(cond, bar) do { unsigned _sp = 0; while (cond) { __builtin_amdgcn_s_sleep(1); \
    if ((++_sp & 255u) == 0u) { if (xb_ld(&(bar)[XB_TMO])) break; if (_sp > XB_SPIN_CAP) { atomicAdd(&(bar)[XB_TMO], 1u); break; } } } } while (0)
struct XcdBarrier { unsigned* bar; unsigned x; volatile LAS unsigned* st; };
DI XcdBarrier xcd_barrier_post(unsigned* bar, volatile LAS unsigned* st, int tid) {
    XcdBarrier b; b.bar = bar; b.x = xb_xcc_id(); b.st = st;
    if (tid == 0) (void)xb_add(&bar[XB_XCNT(b.x)], 1u);
    return b;
}
DI void xcd_barrier_complete(unsigned* bar, unsigned x, unsigned& nloc, unsigned& nx) {
    const unsigned G = gridDim.x * gridDim.y * gridDim.z;
    unsigned sum, cnt, mine, sp = 0u;
    for (;;) {
        sum = 0u; cnt = 0u; mine = 0u;
#pragma unroll
        for (unsigned j = 0; j < 16; ++j) { const unsigned c = xb_ld(&bar[XB_XCNT(j)]); sum += c; cnt += (c > 0u) ? 1u : 0u; mine = (j == x) ? c : mine; }
        if (sum == G) break;
        __builtin_amdgcn_s_sleep(1);
        if ((++sp & 255u) == 0u) { if (xb_ld(&bar[XB_TMO])) break; if (sp > XB_SPIN_CAP) { atomicAdd(&bar[XB_TMO], 1u); break; } }
    }
    nloc = mine > 0u ? mine : 1u; nx = cnt > 0u ? cnt : 1u;
}
DI void xcd_barrier(const XcdBarrier& b, int tid) {
    asm volatile("s_waitcnt vmcnt(0)" ::: "memory");
    __syncthreads();
    if (tid == 0) {
        unsigned* bar = b.bar;
        __builtin_amdgcn_s_waitcnt(0);
        unsigned nloc = b.st[0], nx = b.st[1];
        if (nloc == 0u) { xcd_barrier_complete(bar, b.x, nloc, nx); b.st[0] = nloc; b.st[1] = nx; }
        const unsigned old = xb_add(&bar[XB_XSUB(b.x)], 1u);
        const unsigned gen = old / nloc;
        if (old + 1u == (gen + 1u) * nloc) {
            __builtin_amdgcn_fence(__ATOMIC_RELEASE, "agent");
            asm volatile("s_waitcnt vmcnt(0)" ::: "memory");
            const unsigned og = xb_add(&bar[XB_TOP], 1u);
            const unsigned tg = og / nx;
            if (og + 1u == (tg + 1u) * nx) xb_add(&bar[XB_TOPGEN], 1u);
            else XB_SPIN(xb_ld(&bar[XB_TOPGEN]) == tg, bar);
            __builtin_amdgcn_fence(__ATOMIC_ACQUIRE, "agent");
            xb_add(&bar[XB_XGEN(b.x)], 1u);
            asm volatile("s_waitcnt vmcnt(0)" ::: "memory");
        } else {
            XB_SPIN(xb_ld(&bar[XB_XGEN(b.x)]) == gen, bar);
            __builtin_amdgcn_fence(__ATOMIC_ACQUIRE, "agent");
            asm volatile("s_waitcnt vmcnt(0)" ::: "memory");
        }
    }
    __syncthreads();
}

struct Args { const float* in[24]; float* out; unsigned char* ws; int ph_lo, ph_hi; };
#define ARGIN(A, i) ([&]() -> const float* { int _i = (i); asm volatile("" : "+s"(_i)); return (A).in[_i]; }())
struct Frame {
    LAS unsigned char* lds;
    int wave, vcu, G;
    unsigned char* ws;
};
DI int lane_id() { int l; asm volatile("v_mbcnt_lo_u32_b32 %0, -1, 0\n\tv_mbcnt_hi_u32_b32 %0, -1, %0" : "=v"(l)); return l; }
#define FRAME_LT const int lane = lane_id(); const int tid = F.wave * 64 + lane; (void)tid; (void)lane

DI void phase_pre(const Frame& F, const Args& a) {
    FRAME_LT;
    const int* pos = (const int*)ARGIN(a, 2);
    f32x2* rope = (f32x2*)(F.ws + WS_ROPE);
    const int gt = F.vcu * NTHR + tid, GT = F.G * NTHR;
    for (int i = gt; i < T * 32; i += GT) {
        const int m = i >> 5, fi = i & 31;
        const float angf = (float)pos[m] * c_invf[fi];
        const double ang = (double)angf;
        const double kq = __builtin_rint(ang * 0.63661977236758134308);
        const double y = (ang - kq * 1.5707963267948966192) - kq * 6.123233995736766e-17;
        const double y2 = y * y;
        double sn = y * (1.0 + y2 * (-1.0 / 6 + y2 * (1.0 / 120 + y2 * (-1.0 / 5040 + y2 * (1.0 / 362880 + y2 * (-1.0 / 39916800 + y2 * (1.0 / 6227020800.0)))))));
        double cs = 1.0 + y2 * (-0.5 + y2 * (1.0 / 24 + y2 * (-1.0 / 720 + y2 * (1.0 / 40320 + y2 * (-1.0 / 3628800 + y2 * (1.0 / 479001600.0))))));
        const int q = ((int)kq) & 3;
        double c, s;
        if (q == 0) { c = cs; s = sn; } else if (q == 1) { c = -sn; s = cs; } else if (q == 2) { c = -cs; s = -sn; } else { c = sn; s = -cs; }
        rope[i] = (f32x2){(float)c, (float)s};
    }
    const float* cvec = ARGIN(a, 1); const float* ada_w = ARGIN(a, 3);
    float* modp = (float*)(F.ws + WS_MODP);
    for (int i = gt; i < 16 * 2 * 3072; i += GT) {
        const int j = i % 3072, l = (i / 3072) & 1, sl = i / 6144;
        float a0 = 0.f, a1 = 0.f;
        const float* w = ada_w + ((size_t)l * DM + sl * 64) * 3072 + j;
#pragma unroll 8
        for (int c = 0; c < 64; ++c) { const float wv = w[(size_t)c * 3072]; a0 += siluf_(cvec[sl * 64 + c]) * wv; a1 += siluf_(cvec[DM + sl * 64 + c]) * wv; }
        modp[((sl * 2 + l) * 2 + 0) * 3072 + j] = a0; modp[((sl * 2 + l) * 2 + 1) * 3072 + j] = a1;
    }
}

DI void transpose_item(const float* W, int ldw, int k0, int n0, bf16_t* dst, int ldt, LAS float* scr, int lane) {
#pragma unroll 8
    for (int i = 0; i < 32; ++i) { const int kk = 2 * i + (lane >> 5); scr[kk * 33 + (lane & 31)] = W[(size_t)(k0 + kk) * ldw + n0 + (lane & 31)]; }
    asm volatile("s_waitcnt lgkmcnt(0)" ::: "memory");
    const int c = lane & 7;
#pragma unroll
    for (int j = 0; j < 4; ++j) { const int n = (lane >> 3) + 8 * j; const LAS float* s = scr + (8 * c) * 33 + n;
        u32x4 o; o.x = pk2(s[0 * 33], s[1 * 33]); o.y = pk2(s[2 * 33], s[3 * 33]); o.z = pk2(s[4 * 33], s[5 * 33]); o.w = pk2(s[6 * 33], s[7 * 33]);
        *(u32x4*)(dst + (size_t)n * ldt + 8 * c) = o; }
    asm volatile("s_waitcnt lgkmcnt(0)" ::: "memory");
}
DI int win_dst_row(int n) {
    if (n < 1024) return n;
    if (n < 2048) return 7680 + (n - 1024);
    if (n < 5120) {
        const int isk = n >= 3584; const int x = n - (isk ? 3584 : 2048);
        const int tl = x >> 8, L = x & 255, wc = L >> 6, bj = (L >> 5) & 1, r = L & 31;
        return (isk ? 2560 : 1024) + tl * 256 + 128 * bj + 32 * wc + r;
    }
    if (n < 6656) return 4096 + (n - 5120);
    if (n < 7168) return 8704 + (n - 6656);
    if (n < 7680) return 5632 + (n - 7168);
    if (n < 8192) return 6144 + (n - 7680);
    if (n < 9216) return 6656 + (n - 8192);
    if (n < 10240) return 9216 + (n - 9216);
    return n;
}
DI void phase_norm(const Frame& F, const Args& a, int l) {
    FRAME_LT;
    {
        LAS float* scr = (LAS float*)(F.lds + F.wave * 8704);
        const int gw = F.vcu * NWAVES + F.wave, NGW = F.G * NWAVES;
        const float* w_in = ARGIN(a, 6) + (size_t)l * DM * N_IN;
        const float* proj_a = ARGIN(a, 20) + (size_t)l * 1024 * 1024;
        const float* proj_b = ARGIN(a, 21) + (size_t)l * 512 * 1024;
        const float* proj_c = ARGIN(a, 22) + (size_t)l * 1024 * 1024;
        const float* w_o = ARGIN(a, 23) + (size_t)l * 1024 * 1024;
        const float* lru_wa = ARGIN(a, 9) + (size_t)l * 16 * 64 * 64;
        const float* lru_wx = ARGIN(a, 11) + (size_t)l * 16 * 64 * 64;
        bf16_t* WIN = (bf16_t*)(F.ws + WS_WIN); bf16_t* WP = (bf16_t*)(F.ws + WS_WP); bf16_t* WO = (bf16_t*)(F.ws + WS_WO); bf16_t* LW = (bf16_t*)(F.ws + WS_LRUW);
        constexpr int I_IN = 16 * 416, I_PA = 16 * 32, I_PB = 8 * 32, I_PC = 16 * 32, I_WO = 16 * 32, I_LW = 64;
        constexpr int NITEMS = I_IN + I_PA + I_PB + I_PC + I_WO + I_LW;
        for (int it = gw; it < NITEMS; it += NGW) {
            int r = it;
            if (r < I_IN) { const int kb = r / 416, nb = r % 416; transpose_item(w_in, N_IN, 64 * kb, 32 * nb, WIN + (size_t)win_dst_row(32 * nb) * 1024 + 64 * kb, 1024, scr, lane); continue; } r -= I_IN;
            if (r < I_PA) { const int kb = r / 32, nb = r % 32; transpose_item(proj_a, 1024, 64 * kb, 32 * nb, WP + (size_t)(32 * nb) * 2560 + 64 * kb, 2560, scr, lane); continue; } r -= I_PA;
            if (r < I_PB) { const int kb = r / 32, nb = r % 32; transpose_item(proj_b, 1024, 64 * kb, 32 * nb, WP + (size_t)(32 * nb) * 2560 + 1024 + 64 * kb, 2560, scr, lane); continue; } r -= I_PB;
            if (r < I_PC) { const int kb = r / 32, nb = r % 32; transpose_item(proj_c, 1024, 64 * kb, 32 * nb, WP + (size_t)(32 * nb) * 2560 + 1536 + 64 * kb, 2560, scr, lane); continue; } r -= I_PC;
            if (r < I_WO) { const int kb = r / 32, nb = r % 32; transpose_item(w_o, 1024, 64 * kb, 32 * nb, WO + (size_t)(32 * nb) * 1024 + 64 * kb, 1024, scr, lane); continue; } r -= I_WO;
            { const int mat = r >> 1, nb = r & 1, blk = mat >> 1, gate = mat & 1;
              const float* src = (gate ? lru_wx : lru_wa) + (size_t)blk * 4096;
              transpose_item(src, 64, 0, 32 * nb, LW + (size_t)(blk * 2 + gate) * 4096 + (size_t)(32 * nb) * 64, 64, scr, lane); }
        }
    }
    __syncthreads();
    LAS float* sh = (LAS float*)(F.lds);
    LAS float* sc = (LAS float*)(F.lds + 8192);
    LAS float* a1T = (LAS float*)(F.lds + 16384);
    {
        const float* modp = (const float*)(F.ws + WS_MODP); const float* ada_b = ARGIN(a, 4) + (size_t)l * 3072;
        float* modf = (float*)(F.ws + WS_MODF);
        for (int i = tid; i < 2 * 2048; i += NTHR) {
            const int b = i >> 11, j = i & 2047; float s = ada_b[j];
#pragma unroll
            for (int sl = 0; sl < 16; ++sl) s += modp[((sl * 2 + l) * 2 + b) * 3072 + j];
            if (j < 1024) sh[b * 1024 + j] = s; else sc[b * 1024 + (j - 1024)] = s;
        }
        const int gt = F.vcu * NTHR + tid;
        if (gt < 2 * 3072) { const int b = gt / 3072, j = gt % 3072; float s = ada_b[j];
#pragma unroll
            for (int sl = 0; sl < 16; ++sl) s += modp[((sl * 2 + l) * 2 + b) * 3072 + j];
            modf[(l * 2 + b) * 3072 + j] = s; }
        const float* a1 = ARGIN(a, 16) + (size_t)l * 1024 * 16;
        for (int i = tid; i < 16384; i += NTHR) { const int c = i >> 4, r = i & 15; a1T[r * 1024 + c] = a1[i]; }
    }
    __syncthreads();
    {
        const float* xin = l == 0 ? ARGIN(a, 0) : a.out;
        const float* ng = ARGIN(a, 5) + (size_t)l * 1024;
        bf16_t* H = (bf16_t*)(F.ws + WS_H); float* LR = (float*)(F.ws + WS_LR);
        const int gw = F.vcu * NWAVES + F.wave, NGW = F.G * NWAVES;
        f32x4 gv[4];
#pragma unroll
        for (int j = 0; j < 4; ++j) gv[j] = *(const f32x4*)(ng + 4 * lane + 256 * j);
        for (int m = gw; m < T; m += NGW) {
            const int b = m >> 13;
            const f32x4* xr = (const f32x4*)(xin + (size_t)m * DM) + lane;
            f32x4 v[4]; float ss = 0.f;
#pragma unroll
            for (int j = 0; j < 4; ++j) { v[j] = xr[64 * j]; ss += (v[j].x * v[j].x + v[j].y * v[j].y) + (v[j].z * v[j].z + v[j].w * v[j].w); }
            const float rinv = 1.0f / sqrtf(wave_sum(ss) * (1.f / DM) + EPS);
            float lr[16];
#pragma unroll
            for (int r = 0; r < 16; ++r) lr[r] = 0.f;
            unsigned long long* o8 = (unsigned long long*)(H + (size_t)m * DM) + lane;
#pragma unroll
            for (int j = 0; j < 4; ++j) {
                const int c0 = 4 * lane + 256 * j;
                const f32x4 scv = *(const LAS f32x4*)(sc + b * 1024 + c0), shv = *(const LAS f32x4*)(sh + b * 1024 + c0);
                f32x4 hv;
#pragma unroll
                for (int e = 0; e < 4; ++e) hv[e] = v[j][e] * rinv * gv[j][e] * (1.0f + scv[e]) + shv[e];
                o8[64 * j] = (unsigned long long)pk2(hv.x, hv.y) | ((unsigned long long)pk2(hv.z, hv.w) << 32);
#pragma unroll
                for (int r = 0; r < 16; ++r) { const f32x4 av = *(const LAS f32x4*)(a1T + r * 1024 + c0); lr[r] += (hv.x * av.x + hv.y * av.y) + (hv.z * av.z + hv.w * av.w);
                    if ((r & 3) == 3) asm volatile("" ::: "memory"); }
            }
            float mine = 0.f;
#pragma unroll
            for (int r = 0; r < 16; ++r) { const float s = wave_sum(lr[r]); if (lane == r) mine = s; }
            if (lane < 16) LR[(size_t)m * 16 + lane] = mine;
        }
    }
}

template <int mode> struct EpiG1 {
    static constexpr bool PERM = true, KHOOK = false;
    unsigned char* ws; const float* qn_g; const float* kn_g;
    DI void store_plain(const f32x4 (&acc)[2][2][4][2], bf16_t* base, int ldc, int col0, int row0, float sc) const {
#pragma unroll
        for (int ai = 0; ai < 2; ++ai)
#pragma unroll
            for (int m = 0; m < 4; ++m) { bf16_t* rowp = base + (size_t)(row0 + ai * 128 + m * 16) * ldc + col0;
#pragma unroll
                for (int bj = 0; bj < 2; ++bj) { const f32x4 v0 = acc[ai][bj][m][0] * sc, v1 = acc[ai][bj][m][1] * sc;
                    u32x4 w; w.x = pk2(v0[0], v0[1]); w.y = pk2(v0[2], v0[3]); w.z = pk2(v1[0], v1[1]); w.w = pk2(v1[2], v1[3]);
                    *(u32x4*)(rowp + bj * 128) = w; } }
    }
    DI void operator()(f32x4 (&acc)[2][2][4][2], const pg8::Unit& u, int wr, int wc, int fr, int fq) const {
        const int pn = u.pn, row0 = u.pm * 256 + wr * 64 + fr, cw = wc * 32 + 8 * fq;
        if (mode == 0) {
            if (pn < 4) { store_plain(acc, (bf16_t*)(ws + WS_AX), 1024, pn * 256 + cw, row0, 1.0f); }
            else if (pn < 16) {
                const bool isk = pn >= 10; const int t6 = pn - (isk ? 10 : 4), g = t6 >> 1;
                bf16_t* base = (bf16_t*)(ws + (isk ? WS_K : WS_Q));
                const float* gn = (isk ? kn_g : qn_g) + g * 64;
                const float sc = isk ? 1.0f : 0.125f * LOG2E;
                const f32x2* rope = (const f32x2*)(ws + WS_ROPE);
#pragma unroll
                for (int ai = 0; ai < 2; ++ai)
#pragma unroll
                    for (int m = 0; m < 4; ++m) {
                        const int row = row0 + ai * 128 + m * 16;
                        float ss = 0.f;
#pragma unroll
                        for (int bj = 0; bj < 2; ++bj)
#pragma unroll
                            for (int n = 0; n < 2; ++n) { const f32x4 x = acc[ai][bj][m][n]; ss += (x[0] * x[0] + x[1] * x[1]) + (x[2] * x[2] + x[3] * x[3]); }
                        ss += __shfl_xor(ss, 16); ss += __shfl_xor(ss, 32);
                        const float rinv = 1.0f / sqrtf(ss * (1.f / 64.f) + EPS);
                        const f32x4* rp = (const f32x4*)(rope + (size_t)row * 32 + 8 * fq);
                        u32x4 w1, w2;
#pragma unroll
                        for (int n = 0; n < 2; ++n) {
                            const f32x4 cs0 = rp[2 * n], cs1 = rp[2 * n + 1];
                            const f32x4 g0 = *(const f32x4*)(gn + 8 * fq + 4 * n), g1 = *(const f32x4*)(gn + 32 + 8 * fq + 4 * n);
                            const f32x4 y1 = acc[ai][0][m][n] * rinv * g0, y2 = acc[ai][1][m][n] * rinv * g1;
                            const float a0 = (y1[0] * cs0[0] - y2[0] * cs0[1]) * sc, a1 = (y1[1] * cs0[2] - y2[1] * cs0[3]) * sc;
                            const float a2 = (y1[2] * cs1[0] - y2[2] * cs1[1]) * sc, a3 = (y1[3] * cs1[2] - y2[3] * cs1[3]) * sc;
                            const float b0 = (y2[0] * cs0[0] + y1[0] * cs0[1]) * sc, b1 = (y2[1] * cs0[2] + y1[1] * cs0[3]) * sc;
                            const float b2 = (y2[2] * cs1[0] + y1[2] * cs1[1]) * sc, b3 = (y2[3] * cs1[2] + y1[3] * cs1[3]) * sc;
                            w1[2 * n] = pk2(a0, a1); w1[2 * n + 1] = pk2(a2, a3); w2[2 * n] = pk2(b0, b1); w2[2 * n + 1] = pk2(b2, b3);
                        }
                        bf16_t* rowp = base + (size_t)row * 1536 + t6 * 256 + 64 * wc + 8 * fq;
                        *(u32x4*)(rowp) = w1; *(u32x4*)(rowp + 32) = w2;
                        asm volatile("" ::: "memory");
                    }
            }
            else if (pn < 22) {
                const int t6 = pn - 16, g = t6 >> 1, dsh = 2 * g;
                bf16_t* VT = (bf16_t*)(ws + WS_VT);
#pragma unroll
                for (int ai = 0; ai < 2; ++ai)
#pragma unroll
                    for (int m = 0; m < 4; ++m) {
                        const int row = row0 + ai * 128 + m * 16, b = row >> 13, tt = row & 8191;
                        const int pos = ((tt & ((1 << dsh) - 1)) << (13 - dsh)) + (tt >> dsh);
#pragma unroll
                        for (int bj = 0; bj < 2; ++bj) {
                            const int hh = (t6 & 1) * 4 + bj * 2 + (wc >> 1), dim0 = (wc & 1) * 32 + 8 * fq;
                            bf16_t* p = VT + ((size_t)(((g * 2 + b) * 8 + hh) * 64 + dim0)) * 8192 + pos;
#pragma unroll
                            for (int n = 0; n < 2; ++n)
#pragma unroll
                                for (int j = 0; j < 4; ++j) p[(size_t)(4 * n + j) * 8192] = f2bf(acc[ai][bj][m][n][j]);
                        }
                        asm volatile("" ::: "memory");
                    }
            }
            else if (pn < 24) { store_plain(acc, (bf16_t*)(ws + WS_CQ), 512, (pn - 22) * 256 + cw, row0, 0.08838834764831845f); }
            else if (pn < 26) { store_plain(acc, (bf16_t*)(ws + WS_CK), 512, (pn - 24) * 256 + cw, row0, 1.0f); }
            else { store_plain(acc, (bf16_t*)(ws + WS_CV), 1024, (pn - 26) * 256 + cw, row0, 1.0f); }
        } else {
            if (pn < 10) {
                bf16_t* Y; int col0;
                if (pn < 4) { Y = (bf16_t*)(ws + WS_YA); col0 = pn * 256; } else if (pn < 6) { Y = (bf16_t*)(ws + WS_YB); col0 = (pn - 4) * 256; } else { Y = (bf16_t*)(ws + WS_YC); col0 = (pn - 6) * 256; }
#pragma unroll
                for (int ai = 0; ai < 2; ++ai)
#pragma unroll
                    for (int m = 0; m < 4; ++m) { bf16_t* rowp = Y + (size_t)(row0 + ai * 128 + m * 16) * 1024 + col0 + cw;
#pragma unroll
                        for (int bj = 0; bj < 2; ++bj) { const u32x4 y = *(const u32x4*)(rowp + bj * 128); const f32x4 v0 = acc[ai][bj][m][0], v1 = acc[ai][bj][m][1];
                            u32x4 w;
                            w.x = pk2(bflo(y.x) * siluf_(v0[0]), bfhi(y.x) * siluf_(v0[1])); w.y = pk2(bflo(y.y) * siluf_(v0[2]), bfhi(y.y) * siluf_(v0[3]));
                            w.z = pk2(bflo(y.z) * siluf_(v1[0]), bfhi(y.z) * siluf_(v1[1])); w.w = pk2(bflo(y.w) * siluf_(v1[2]), bfhi(y.w) * siluf_(v1[3]));
                            *(u32x4*)(rowp + bj * 128) = w; } }
            } else {
                bf16_t* MG = (bf16_t*)(ws + WS_MG); const int col0 = (pn - 10) * 256 + cw;
#pragma unroll
                for (int ai = 0; ai < 2; ++ai)
#pragma unroll
                    for (int m = 0; m < 4; ++m) { bf16_t* rowp = MG + (size_t)(row0 + ai * 128 + m * 16) * 3072 + col0;
#pragma unroll
                        for (int bj = 0; bj < 2; ++bj) { const f32x4 v0 = acc[ai][bj][m][0], v1 = acc[ai][bj][m][1];
                            u32x4 w; w.x = pk2(sigmoidf_(v0[0]), sigmoidf_(v0[1])); w.y = pk2(sigmoidf_(v0[2]), sigmoidf_(v0[3])); w.z = pk2(sigmoidf_(v1[0]), sigmoidf_(v1[1])); w.w = pk2(sigmoidf_(v1[2]), sigmoidf_(v1[3]));
                            *(u32x4*)(rowp + bj * 128) = w; } }
            }
        }
    }
};

struct EpiG2 {
    static constexpr bool PERM = true, KHOOK = true;
    unsigned char* ws;
    DI void scale(f32x4 (&acc)[2][2][4][2], const pg8::Unit& u, int wr, int wc, int fr, int fq, int brn, int brd) const {
        const bf16_t* MG = (const bf16_t*)(ws + WS_MG);
        const int row0 = u.pm * 256 + wr * 64 + fr, col0 = u.pn * 256 + wc * 32 + 8 * fq;
#pragma unroll
        for (int ai = 0; ai < 2; ++ai)
#pragma unroll
            for (int m = 0; m < 4; ++m) { const bf16_t* rowp = MG + (size_t)(row0 + ai * 128 + m * 16) * 3072 + col0;
#pragma unroll
                for (int bj = 0; bj < 2; ++bj) {
                    const u32x4 nu = *(const u32x4*)(rowp + brn * 1024 + bj * 128);
                    float r[8] = {bflo(nu.x), bfhi(nu.x), bflo(nu.y), bfhi(nu.y), bflo(nu.z), bfhi(nu.z), bflo(nu.w), bfhi(nu.w)};
                    if (brd >= 0) { const u32x4 de = *(const u32x4*)(rowp + brd * 1024 + bj * 128);
                        const float d[8] = {bflo(de.x), bfhi(de.x), bflo(de.y), bfhi(de.y), bflo(de.z), bfhi(de.z), bflo(de.w), bfhi(de.w)};
#pragma unroll
                        for (int e = 0; e < 8; ++e) r[e] = r[e] * __builtin_amdgcn_rcpf(d[e]); }
#pragma unroll
                    for (int e = 0; e < 4; ++e) { acc[ai][bj][m][0][e] *= r[e]; acc[ai][bj][m][1][e] *= r[4 + e]; }
                }
                asm volatile("" ::: "memory"); }
    }
    DI void khook(f32x4 (&acc)[2][2][4][2], const pg8::Unit& u, int t, int wr, int wc, int fr, int fq) const {
        if (t == 16 || t == 24) { const int brn = (t == 16) ? 0 : 1; scale(acc, u, wr, wc, fr, fq, brn, brn + 1); }
    }
    DI void operator()(f32x4 (&acc)[2][2][4][2], const pg8::Unit& u, int wr, int wc, int fr, int fq) const {
        scale(acc, u, wr, wc, fr, fq, 2, -1);
        bf16_t* O = (bf16_t*)(ws + WS_MERGED);
        const int row0 = u.pm * 256 + wr * 64 + fr, col0 = u.pn * 256 + wc * 32 + 8 * fq;
#pragma unroll
        for (int ai = 0; ai < 2; ++ai)
#pragma unroll
            for (int m = 0; m < 4; ++m) { bf16_t* rowp = O + (size_t)(row0 + ai * 128 + m * 16) * 1024 + col0;
#pragma unroll
                for (int bj = 0; bj < 2; ++bj) { const f32x4 v0 = acc[ai][bj][m][0], v1 = acc[ai][bj][m][1];
                    u32x4 w; w.x = pk2(v0[0], v0[1]); w.y = pk2(v0[2], v0[3]); w.z = pk2(v1[0], v1[1]); w.w = pk2(v1[2], v1[3]);
                    *(u32x4*)(rowp + bj * 128) = w; } }
    }
};

struct EpiG3 {
    static constexpr bool PERM = false, KHOOK = false;
    const float* xin; float* out; const float* gate;
    DI void operator()(f32x4 (&acc)[2][2][4][2], const pg8::Unit& u, int wr, int wc, int fr, int fq) const {
        const int row0 = u.pm * 256 + wr * 64 + fr, col0 = u.pn * 256 + wc * 32 + 4 * fq, b = (u.pm * 256) >> 13;
        f32x4 gv[2][2];
#pragma unroll
        for (int bj = 0; bj < 2; ++bj)
#pragma unroll
            for (int n = 0; n < 2; ++n) gv[bj][n] = *(const f32x4*)(gate + b * 3072 + col0 + bj * 128 + n * 16);
#pragma unroll
        for (int ai = 0; ai < 2; ++ai)
#pragma unroll
            for (int m = 0; m < 4; ++m) { const size_t off = (size_t)(row0 + ai * 128 + m * 16) * 1024 + col0;
#pragma unroll
                for (int bj = 0; bj < 2; ++bj)
#pragma unroll
                    for (int n = 0; n < 2; ++n) { const f32x4 xv = *(const f32x4*)(xin + off + bj * 128 + n * 16);
                        *(f32x4*)(out + off + bj * 128 + n * 16) = xv + gv[bj][n] * acc[ai][bj][m][n]; } }
    }
};

DI void att_wave_unit(int id, unsigned char* ws, int lane) {
    bf16_t* Qb = (bf16_t*)(ws + WS_Q); const bf16_t* Kb = (const bf16_t*)(ws + WS_K); const bf16_t* VT = (const bf16_t*)(ws + WS_VT); float* LSE = (float*)(ws + WS_LSE);
    const int x = id & 255, hh = (id >> 8) & 7, b = (id >> 11) & 1, g = id >> 12;
    const int dsh = 2 * g, cpc = 256 >> dsh, r = x >> (8 - dsh), ci = x & (cpc - 1), m0 = 32 * ci, L = 8192 >> dsh;
    const int ql = lane & 31, h = lane >> 5;
    const size_t tokq = (size_t)b * 8192 + ((size_t)(m0 + ql) << dsh) + r;
    const int colb = g * 512 + hh * 64;
    const bf16_t* qp = Qb + tokq * 1536 + colb + 8 * h;
    bf16x8 qf[4];
#pragma unroll
    for (int kk = 0; kk < 4; ++kk) qf[kk] = *(const bf16x8*)(qp + 16 * kk);
    f32x16 st[5];
    float mx = -INFINITY;
#pragma unroll
    for (int kt = 0; kt < 5; ++kt) {
        const int kb = m0 - 128 + 32 * kt;
        f32x16 acc;
#pragma unroll
        for (int i = 0; i < 16; ++i) acc[i] = 0.f;
        if (kb >= 0) {
            const size_t tokk = (size_t)b * 8192 + ((size_t)(kb + ql) << dsh) + r;
            const bf16_t* kp = Kb + tokk * 1536 + colb + 8 * h;
#pragma unroll
            for (int kk = 0; kk < 4; ++kk) { const bf16x8 kf = *(const bf16x8*)(kp + 16 * kk); acc = MFMA32(kf, qf[kk], acc); }
#pragma unroll
            for (int i = 0; i < 16; ++i) { const int rel = (m0 + ql) - (kb + crow(i, h)); if (rel < 0 || rel > 128) acc[i] = -INFINITY; mx = fmaxf(mx, acc[i]); }
        } else {
#pragma unroll
            for (int i = 0; i < 16; ++i) acc[i] = -INFINITY;
        }
        st[kt] = acc;
    }
    mx = fmaxf(mx, __shfl_xor(mx, 32));
    float l = 0.f;
#pragma unroll
    for (int kt = 0; kt < 5; ++kt)
#pragma unroll
        for (int i = 0; i < 16; ++i) { const float p = __builtin_amdgcn_exp2f(st[kt][i] - mx); st[kt][i] = p; l += p; }
    l += __shfl_xor(l, 32);
    f32x16 o[2];
#pragma unroll
    for (int i = 0; i < 16; ++i) { o[0][i] = 0.f; o[1][i] = 0.f; }
    const bf16_t* vbase = VT + ((size_t)(((g * 2 + b) * 8 + hh) * 64 + ql)) * 8192 + (size_t)r * L + 4 * h;
#pragma unroll
    for (int kt = 0; kt < 5; ++kt) {
        const int kb = m0 - 128 + 32 * kt;
        if (kb >= 0) {
#pragma unroll
            for (int s = 0; s < 2; ++s) {
                const bf16x8 pb = pack_step(st[kt], s);
#pragma unroll
                for (int db = 0; db < 2; ++db) {
                    const bf16_t* vp = vbase + (size_t)db * 32 * 8192 + kb + 16 * s;
                    const s16x4 lo = *(const s16x4*)(vp), hi = *(const s16x4*)(vp + 8);
                    const bf16x8 va = __builtin_shufflevector(lo, hi, 0, 1, 2, 3, 4, 5, 6, 7);
                    o[db] = MFMA32(va, pb, o[db]);
                }
            }
        }
    }
    const float inv = 1.0f / l;
    bf16_t* op = Qb + tokq * 1536 + colb + 4 * h;
#pragma unroll
    for (int db = 0; db < 2; ++db)
#pragma unroll
        for (int gq = 0; gq < 4; ++gq) {
            u32x2 w; w.x = pk2(o[db][4 * gq] * inv, o[db][4 * gq + 1] * inv); w.y = pk2(o[db][4 * gq + 2] * inv, o[db][4 * gq + 3] * inv);
            *(u32x2*)(op + 32 * db + 8 * gq) = w;
        }
    if (h == 0) LSE[(tokq * 3 + g) * 8 + hh] = mx + __builtin_amdgcn_logf(l);
}

DI void yb_unit(int u, const Frame& F) {
    FRAME_LT;
    const bf16_t* O = (const bf16_t*)(F.ws + WS_Q); const float* LSE = (const float*)(F.ws + WS_LSE); bf16_t* YB = (bf16_t*)(F.ws + WS_YB);
#pragma unroll
    for (int i = 0; i < 8; ++i) {
        const int it = tid + NTHR * i; const size_t tok = (size_t)u * 64 + (it >> 6); const int c8 = it & 63, hs = c8 >> 3, d0 = (c8 & 7) * 8;
        const float l0 = LSE[(tok * 3 + 0) * 8 + hs], l1 = LSE[(tok * 3 + 1) * 8 + hs], l2 = LSE[(tok * 3 + 2) * 8 + hs];
        const float mx = fmaxf(l0, fmaxf(l1, l2));
        float w0 = __builtin_amdgcn_exp2f(l0 - mx), w1 = __builtin_amdgcn_exp2f(l1 - mx), w2 = __builtin_amdgcn_exp2f(l2 - mx);
        const float inv = 1.0f / (w0 + w1 + w2); w0 *= inv; w1 *= inv; w2 *= inv;
        const bf16_t* op = O + tok * 1536 + hs * 64 + d0;
        const u32x4 a = *(const u32x4*)(op), bq = *(const u32x4*)(op + 512), c = *(const u32x4*)(op + 1024);
        u32x4 w;
        w.x = pk2(w0 * bflo(a.x) + w1 * bflo(bq.x) + w2 * bflo(c.x), w0 * bfhi(a.x) + w1 * bfhi(bq.x) + w2 * bfhi(c.x));
        w.y = pk2(w0 * bflo(a.y) + w1 * bflo(bq.y) + w2 * bflo(c.y), w0 * bfhi(a.y) + w1 * bfhi(bq.y) + w2 * bfhi(c.y));
        w.z = pk2(w0 * bflo(a.z) + w1 * bflo(bq.z) + w2 * bflo(c.z), w0 * bfhi(a.z) + w1 * bfhi(bq.z) + w2 * bfhi(c.z));
        w.w = pk2(w0 * bflo(a.w) + w1 * bflo(bq.w) + w2 * bflo(c.w), w0 * bfhi(a.w) + w1 * bfhi(bq.w) + w2 * bfhi(c.w));
        *(u32x4*)(YB + tok * 1024 + hs * 64 + d0) = w;
    }
}

DI void gla_cumsum(LAS float* Bc, LAS float* tot, const float* LR, const float* a2, const float* ab, int b, int hd, int n, int tid) {
    const int kd = tid & 127, part = tid >> 7, col = hd * 128 + kd;
    float w[16];
#pragma unroll
    for (int r = 0; r < 16; ++r) w[r] = a2[r * 512 + col];
    const float bias = ab[col];
    const size_t tok0 = (size_t)b * 8192 + n * 64 + part * 16;
    float run = 0.f;
#pragma unroll 4
    for (int s = 0; s < 16; ++s) {
        const f32x4* lr = (const f32x4*)(LR + (tok0 + s) * 16);
        float pre = bias;
#pragma unroll
        for (int q = 0; q < 4; ++q) { const f32x4 v = lr[q]; pre += v[0] * w[4 * q] + v[1] * w[4 * q + 1] + v[2] * w[4 * q + 2] + v[3] * w[4 * q + 3]; }
        const float la = (fminf(pre, 0.f) - __logf(1.0f + __expf(-fabsf(pre)))) * (1.0f / 16.0f);
        run += la; Bc[(part * 16 + s) * 128 + kd] = run;
    }
    tot[part * 128 + kd] = run;
    __syncthreads();
    float off = 0.f;
#pragma unroll
    for (int p = 0; p < 3; ++p) if (p < part) off += tot[p * 128 + kd];
    if (part > 0) {
#pragma unroll 4
        for (int s = 0; s < 16; ++s) Bc[(part * 16 + s) * 128 + kd] += off;
    }
    __syncthreads();
}
constexpr int G_BC = 0, G_TOT = 32768, G_A = 34816;
constexpr int G1_KET = G_A, G1_VTL = G1_KET + 128 * 72 * 2;
constexpr int G3_QD = G_A, G3_KI = G3_QD + 64 * 136 * 2, G3_VTL = G3_KI + 64 * 136 * 2, G3_SSQ = G3_VTL + 256 * 72 * 2;
DI void gla_load_vt(LAS bf16_t* VTL, const bf16_t* CV, size_t tok0, int hd, int tid) {
#pragma unroll
    for (int i = 0; i < 4; ++i) { const int c = tid + NTHR * i, s = c >> 5, vd0 = (c & 31) * 8;
        const u32x4 raw = *(const u32x4*)(CV + (tok0 + s) * 1024 + hd * 256 + vd0);
        const unsigned wv[4] = {raw.x, raw.y, raw.z, raw.w};
#pragma unroll
        for (int e = 0; e < 4; ++e) { VTL[(vd0 + 2 * e) * 72 + s] = (bf16_t)(wv[e] & 0xffffu); VTL[(vd0 + 2 * e + 1) * 72 + s] = (bf16_t)(wv[e] >> 16); } }
}
DI void gla1_unit(int u, const Frame& F, const Args& a, int l) {
    FRAME_LT;
    const int n = u & 127, bh = u >> 7, b = bh >> 2, hd = bh & 3;
    LAS float* Bc = (LAS float*)(F.lds + G_BC); LAS float* tot = (LAS float*)(F.lds + G_TOT);
    LAS bf16_t* KeT = (LAS bf16_t*)(F.lds + G1_KET); LAS bf16_t* VTL = (LAS bf16_t*)(F.lds + G1_VTL);
    const bf16_t* CK = (const bf16_t*)(F.ws + WS_CK); const bf16_t* CV = (const bf16_t*)(F.ws + WS_CV);
    gla_cumsum(Bc, tot, (const float*)(F.ws + WS_LR), ARGIN(a, 17) + (size_t)l * 16 * 512, ARGIN(a, 18) + (size_t)l * 512, b, hd, n, tid);
    const size_t tok0 = (size_t)b * 8192 + n * 64;
    if (tid < 128) ((float*)(F.ws + WS_GDEC))[((size_t)bh * 128 + n) * 128 + tid] = __expf(Bc[63 * 128 + tid]);
#pragma unroll
    for (int i = 0; i < 2; ++i) { const int c = tid + NTHR * i, s = c >> 4, kd0 = (c & 15) * 8;
        const u32x4 raw = *(const u32x4*)(CK + (tok0 + s) * 512 + hd * 128 + kd0);
        const unsigned wv[4] = {raw.x, raw.y, raw.z, raw.w};
#pragma unroll
        for (int e = 0; e < 8; ++e) { const float kv = (e & 1) ? bfhi(wv[e >> 1]) : bflo(wv[e >> 1]);
            const float f = __expf(Bc[63 * 128 + kd0 + e] - Bc[s * 128 + kd0 + e]); KeT[(kd0 + e) * 72 + s] = f2bf(kv * f); } }
    gla_load_vt(VTL, CV, tok0, hd, tid);
    __syncthreads();
    const int ql = lane & 31, h = lane >> 5, w = F.wave;
    bf16_t* KV = (bf16_t*)(F.ws + WS_KV) + ((size_t)bh * 128 + n) * 256 * 128;
    bf16x8 vb[4];
#pragma unroll
    for (int kk = 0; kk < 4; ++kk) vb[kk] = *(const LAS bf16x8*)(VTL + (32 * w + ql) * 72 + 16 * kk + 8 * h);
#pragma unroll
    for (int mt = 0; mt < 4; ++mt) {
        f32x16 acc;
#pragma unroll
        for (int i = 0; i < 16; ++i) acc[i] = 0.f;
#pragma unroll
        for (int kk = 0; kk < 4; ++kk) { const bf16x8 ka = *(const LAS bf16x8*)(KeT + (32 * mt + ql) * 72 + 16 * kk + 8 * h); acc = MFMA32(ka, vb[kk], acc); }
        bf16_t* dst = KV + (size_t)(32 * w + ql) * 128 + 32 * mt + 4 * h;
#pragma unroll
        for (int gq = 0; gq < 4; ++gq) { u32x2 wv; wv.x = pk2(acc[4 * gq], acc[4 * gq + 1]); wv.y = pk2(acc[4 * gq + 2], acc[4 * gq + 3]); *(u32x2*)(dst + 8 * gq) = wv; }
    }
    __syncthreads();
}
DI void gla2_unit(int u, const Frame& F) {
    FRAME_LT;
    const int gid = u * NTHR + tid, pr = gid & 63, vd = (gid >> 6) & 255, bh = gid >> 14;
    unsigned* p = (unsigned*)(F.ws + WS_KV) + ((size_t)bh * 128 * 256 + vd) * 64 + pr;
    const f32x2* dp = (const f32x2*)(F.ws + WS_GDEC) + (size_t)bh * 128 * 64 + pr;
    float s0 = 0.f, s1 = 0.f;
    for (int n0 = 0; n0 < 128; n0 += 8) {
        unsigned cur[8]; f32x2 dc[8];
#pragma unroll
        for (int j = 0; j < 8; ++j) { cur[j] = p[(size_t)(n0 + j) * 16384]; dc[j] = dp[(size_t)(n0 + j) * 64]; }
#pragma unroll
        for (int j = 0; j < 8; ++j) { p[(size_t)(n0 + j) * 16384] = pk2(s0, s1); s0 = dc[j].x * s0 + bflo(cur[j]); s1 = dc[j].y * s1 + bfhi(cur[j]); }
    }
}
DI void gla3_unit(int u, const Frame& F, const Args& a, int l) {
    FRAME_LT;
    const int n = u & 127, bh = u >> 7, b = bh >> 2, hd = bh & 3;
    LAS float* Bc = (LAS float*)(F.lds + G_BC); LAS float* tot = (LAS float*)(F.lds + G_TOT);
    LAS bf16_t* QD = (LAS bf16_t*)(F.lds + G3_QD); LAS bf16_t* KI = (LAS bf16_t*)(F.lds + G3_KI); LAS bf16_t* VTL = (LAS bf16_t*)(F.lds + G3_VTL);
    LAS float* SSQ = (LAS float*)(F.lds + G3_SSQ);
    const bf16_t* CQ = (const bf16_t*)(F.ws + WS_CQ); const bf16_t* CK = (const bf16_t*)(F.ws + WS_CK); bf16_t* CV = (bf16_t*)(F.ws + WS_CV);
    gla_cumsum(Bc, tot, (const float*)(F.ws + WS_LR), ARGIN(a, 17) + (size_t)l * 16 * 512, ARGIN(a, 18) + (size_t)l * 512, b, hd, n, tid);
    const size_t tok0 = (size_t)b * 8192 + n * 64;
#pragma unroll
    for (int i = 0; i < 2; ++i) { const int c = tid + NTHR * i, s = c >> 4, kd0 = (c & 15) * 8;
        const u32x4 rq = *(const u32x4*)(CQ + (tok0 + s) * 512 + hd * 128 + kd0), rk = *(const u32x4*)(CK + (tok0 + s) * 512 + hd * 128 + kd0);
        const unsigned wq[4] = {rq.x, rq.y, rq.z, rq.w}, wk[4] = {rk.x, rk.y, rk.z, rk.w};
        u32x4 oq, ok;
#pragma unroll
        for (int e = 0; e < 4; ++e) { const float b0 = Bc[s * 128 + kd0 + 2 * e], b1 = Bc[s * 128 + kd0 + 2 * e + 1];
            oq[e] = pk2(bflo(wq[e]) * __expf(b0), bfhi(wq[e]) * __expf(b1)); ok[e] = pk2(bflo(wk[e]) * __expf(-b0), bfhi(wk[e]) * __expf(-b1)); }
        *(LAS u32x4*)(QD + s * 136 + kd0) = oq; *(LAS u32x4*)(KI + s * 136 + kd0) = ok; }
    gla_load_vt(VTL, CV, tok0, hd, tid);
    __syncthreads();
    const int ql = lane & 31, h = lane >> 5, w = F.wave;
    f32x16 at00, at01, at11;
#pragma unroll
    for (int i = 0; i < 16; ++i) { at00[i] = 0.f; at01[i] = 0.f; at11[i] = 0.f; }
#pragma unroll
    for (int kk = 0; kk < 8; ++kk) {
        const bf16x8 k0 = *(const LAS bf16x8*)(KI + (ql) * 136 + 16 * kk + 8 * h), k1 = *(const LAS bf16x8*)(KI + (32 + ql) * 136 + 16 * kk + 8 * h);
        const bf16x8 q0 = *(const LAS bf16x8*)(QD + (ql) * 136 + 16 * kk + 8 * h), q1 = *(const LAS bf16x8*)(QD + (32 + ql) * 136 + 16 * kk + 8 * h);
        at00 = MFMA32(k0, q0, at00); at01 = MFMA32(k0, q1, at01); at11 = MFMA32(k1, q1, at11);
    }
#pragma unroll
    for (int i = 0; i < 16; ++i) { const int s = crow(i, h); if (s > ql) { at00[i] = 0.f; at11[i] = 0.f; } }
    const bf16_t* PV = (const bf16_t*)(F.ws + WS_KV) + (((size_t)bh * 128 + n) * 256 + 32 * w + ql) * 128 + 8 * h;
    f32x16 o[2];
#pragma unroll
    for (int i = 0; i < 16; ++i) { o[0][i] = 0.f; o[1][i] = 0.f; }
    const LAS bf16_t* vrow = VTL + (32 * w + ql) * 72 + 4 * h;
#pragma unroll
    for (int s = 0; s < 2; ++s) {
        { const s16x4 lo = *(const LAS s16x4*)(vrow + 16 * s), hi = *(const LAS s16x4*)(vrow + 16 * s + 8);
          const bf16x8 va = __builtin_shufflevector(lo, hi, 0, 1, 2, 3, 4, 5, 6, 7);
          o[0] = MFMA32(va, pack_step(at00, s), o[0]); o[1] = MFMA32(va, pack_step(at01, s), o[1]); }
        { const s16x4 lo = *(const LAS s16x4*)(vrow + 32 + 16 * s), hi = *(const LAS s16x4*)(vrow + 32 + 16 * s + 8);
          const bf16x8 va = __builtin_shufflevector(lo, hi, 0, 1, 2, 3, 4, 5, 6, 7);
          o[1] = MFMA32(va, pack_step(at11, s), o[1]); }
    }
#pragma unroll
    for (int kk = 0; kk < 8; ++kk) {
        const bf16x8 pa = *(const bf16x8*)(PV + 16 * kk);
        const bf16x8 q0 = *(const LAS bf16x8*)(QD + (ql) * 136 + 16 * kk + 8 * h), q1 = *(const LAS bf16x8*)(QD + (32 + ql) * 136 + 16 * kk + 8 * h);
        o[0] = MFMA32(pa, q0, o[0]); o[1] = MFMA32(pa, q1, o[1]);
    }
#pragma unroll
    for (int qt = 0; qt < 2; ++qt) { float ss = 0.f;
#pragma unroll
        for (int i = 0; i < 16; ++i) ss += o[qt][i] * o[qt][i];
        ss += __shfl_xor(ss, 32);
        if (h == 0) SSQ[w * 64 + 32 * qt + ql] = ss; }
    __syncthreads();
    const float* ong = ARGIN(a, 19) + (size_t)l * 256;
#pragma unroll
    for (int qt = 0; qt < 2; ++qt) {
        float ss = 0.f;
#pragma unroll
        for (int ww = 0; ww < 8; ++ww) ss += SSQ[ww * 64 + 32 * qt + ql];
        const float rinv = 1.0f / sqrtf(ss * (1.f / 256.f) + EPS);
        bf16_t* dst = CV + (tok0 + 32 * qt + ql) * 1024 + hd * 256 + 32 * w + 4 * h;
#pragma unroll
        for (int gq = 0; gq < 4; ++gq) { const f32x4 gv = *(const f32x4*)(ong + 32 * w + 8 * gq + 4 * h);
            u32x2 wv; wv.x = pk2(o[qt][4 * gq] * rinv * gv[0], o[qt][4 * gq + 1] * rinv * gv[1]); wv.y = pk2(o[qt][4 * gq + 2] * rinv * gv[2], o[qt][4 * gq + 3] * rinv * gv[3]);
            *(u32x2*)(dst + 8 * gq) = wv; }
    }
    __syncthreads();
}

constexpr int L_XC = 0, L_AL = 17408, L_UL = L_AL + 32768, L_PA = L_UL + 32768, L_PH = L_PA + 2048;
template <bool FINAL> DI void lru_unit(int u, const Frame& F, const Args& a, int l) {
    FRAME_LT;
    const int cg = u & 7, c = (u >> 3) & 127, b = u >> 10, ch0 = cg * 128;
    LAS bf16_t* XC = (LAS bf16_t*)(F.lds + L_XC); LAS float* AL = (LAS float*)(F.lds + L_AL); LAS float* UL = (LAS float*)(F.lds + L_UL);
    LAS float* PA = (LAS float*)(F.lds + L_PA); LAS float* PH = (LAS float*)(F.lds + L_PH);
    const bf16_t* AX = (const bf16_t*)(F.ws + WS_AX);
    const float* cw = ARGIN(a, 7) + (size_t)l * 4 * 1024; const float* cb = ARGIN(a, 8) + (size_t)l * 1024;
#pragma unroll
    for (int i = 0; i < 2; ++i) { const int q = tid + NTHR * i, s = q >> 4, cc = (q & 15) * 8, t = c * 64 + s;
        float acc[8];
        { const f32x4 b0 = *(const f32x4*)(cb + ch0 + cc), b1 = *(const f32x4*)(cb + ch0 + cc + 4);
#pragma unroll
          for (int e = 0; e < 4; ++e) { acc[e] = b0[e]; acc[4 + e] = b1[e]; } }
#pragma unroll
        for (int k = 0; k < 4; ++k) { const int tt = t - 3 + k;
            if (tt >= 0) { const u32x4 raw = *(const u32x4*)(AX + ((size_t)b * 8192 + tt) * 1024 + ch0 + cc);
                const f32x4 w0 = *(const f32x4*)(cw + k * 1024 + ch0 + cc), w1 = *(const f32x4*)(cw + k * 1024 + ch0 + cc + 4);
                acc[0] += w0[0] * bflo(raw.x); acc[1] += w0[1] * bfhi(raw.x); acc[2] += w0[2] * bflo(raw.y); acc[3] += w0[3] * bfhi(raw.y);
                acc[4] += w1[0] * bflo(raw.z); acc[5] += w1[1] * bfhi(raw.z); acc[6] += w1[2] * bflo(raw.w); acc[7] += w1[3] * bfhi(raw.w); } }
        u32x4 o; o.x = pk2(acc[0], acc[1]); o.y = pk2(acc[2], acc[3]); o.z = pk2(acc[4], acc[5]); o.w = pk2(acc[6], acc[7]);
        *(LAS u32x4*)(XC + s * 136 + cc) = o; }
    __syncthreads();
    {
        const int w = F.wave, bl = w >> 2, mt = (w >> 1) & 1, nt = w & 1, ql = lane & 31, h = lane >> 5;
        const bf16_t* LW = (const bf16_t*)(F.ws + WS_LRUW) + (size_t)((cg * 2 + bl) * 2) * 4096;
        f32x16 ga, gx;
#pragma unroll
        for (int i = 0; i < 16; ++i) { ga[i] = 0.f; gx[i] = 0.f; }
#pragma unroll
        for (int kk = 0; kk < 4; ++kk) {
            const bf16x8 xa = *(const LAS bf16x8*)(XC + (32 * mt + ql) * 136 + bl * 64 + 16 * kk + 8 * h);
            const bf16x8 wa = *(const bf16x8*)(LW + (32 * nt + ql) * 64 + 16 * kk + 8 * h), wx = *(const bf16x8*)(LW + 4096 + (32 * nt + ql) * 64 + 16 * kk + 8 * h);
            ga = MFMA32(xa, wa, ga); gx = MFMA32(xa, wx, gx);
        }
        const int chl = bl * 64 + 32 * nt + ql, chg = ch0 + chl;
        const float ba = ARGIN(a, 10)[(size_t)l * 1024 + chg], bx = ARGIN(a, 12)[(size_t)l * 1024 + chg], lam = ARGIN(a, 13)[(size_t)l * 1024 + chg];
        const float sp = log1pf(__expf(-lam));
#pragma unroll
        for (int i = 0; i < 16; ++i) { const int tok = 32 * mt + crow(i, h);
            const float r = sigmoidf_(ga[i] + ba), ig = sigmoidf_(gx[i] + bx), la = -8.0f * r * sp, av = __expf(la);
            const float xc = bf2f(XC[tok * 136 + chl]);
            AL[tok * 128 + chl] = av; UL[tok * 128 + chl] = sqrtf(fmaxf(1.0f - av * av, 0.f)) * (ig * xc); }
    }
    __syncthreads();
    const int ch = tid & 127, part = tid >> 7, chg = ch0 + ch;
    float A = 1.f, H = 0.f;
#pragma unroll 4
    for (int s = 0; s < 16; ++s) { const float av = AL[(part * 16 + s) * 128 + ch], uv = UL[(part * 16 + s) * 128 + ch]; H = av * H + uv; A *= av; }
    PA[part * 128 + ch] = A; PH[part * 128 + ch] = H;
    __syncthreads();
    const size_t cidx = ((size_t)b * 128 + c) * 1024 + chg;
    if (!FINAL) {
        if (part == 0) { float At = 1.f, Ht = 0.f;
#pragma unroll
            for (int p = 0; p < 4; ++p) { Ht = PA[p * 128 + ch] * Ht + PH[p * 128 + ch]; At *= PA[p * 128 + ch]; }
            ((float*)(F.ws + WS_LA))[cidx] = At; ((float*)(F.ws + WS_LH))[cidx] = Ht; }
    } else {
        float st = ((const float*)(F.ws + WS_LC))[cidx];
#pragma unroll
        for (int p = 0; p < 3; ++p) if (p < part) st = PA[p * 128 + ch] * st + PH[p * 128 + ch];
        bf16_t* YA = (bf16_t*)(F.ws + WS_YA) + ((size_t)b * 8192 + c * 64 + part * 16) * 1024 + chg;
#pragma unroll 4
        for (int s = 0; s < 16; ++s) { const float av = AL[(part * 16 + s) * 128 + ch], uv = UL[(part * 16 + s) * 128 + ch]; st = av * st + uv; YA[(size_t)s * 1024] = f2bf(st); }
    }
    __syncthreads();
}
DI void lru2_unit(int u, const Frame& F) {
    FRAME_LT;
    const int gid = u * NTHR + tid, ch = gid & 1023, b = gid >> 10;
    const float* LA = (const float*)(F.ws + WS_LA) + (size_t)b * 128 * 1024 + ch; const float* LH = (const float*)(F.ws + WS_LH) + (size_t)b * 128 * 1024 + ch;
    float* LC = (float*)(F.ws + WS_LC) + (size_t)b * 128 * 1024 + ch;
    float st = 0.f;
    for (int c0 = 0; c0 < 128; c0 += 8) { float av[8], hv[8];
#pragma unroll
        for (int j = 0; j < 8; ++j) { av[j] = LA[(size_t)(c0 + j) * 1024]; hv[j] = LH[(size_t)(c0 + j) * 1024]; }
#pragma unroll
        for (int j = 0; j < 8; ++j) { LC[(size_t)(c0 + j) * 1024] = st; st = av[j] * st + hv[j]; } }
}

constexpr int N_PHASES = 17;
__global__ void __launch_bounds__(NTHR, 2) hybrid_fwd(Args args) {
    extern __shared__ __attribute__((aligned(16))) unsigned char lds_raw[];
    Frame F;
    F.lds = (LAS unsigned char*)lds_raw;
    const int wave_s = __builtin_amdgcn_readfirstlane((int)threadIdx.x >> 6);
    F.wave = wave_s;
    F.G = gridDim.x; { const int bx = blockIdx.x; F.vcu = (F.G % 8 == 0) ? (bx % 8) * (F.G / 8) + bx / 8 : bx; }
    F.ws = args.ws;
    volatile LAS unsigned* MISC = (volatile LAS unsigned*)(F.lds + MISC_OFF);
    { const int tid0 = wave_s * 64 + lane_id();
      for (int u = tid0; u < (LDS_BYTES - LDSCTL_OFF) / 4; u += NTHR) ((LAS unsigned*)(F.lds + LDSCTL_OFF))[u] = 0u; }
    __syncthreads();
    XcdBarrier bar; bar.bar = (unsigned*)(F.ws + WS_CTL); bar.x = 0; bar.st = nullptr;
#if !MK_SPLIT
    bar = xcd_barrier_post((unsigned*)(F.ws + WS_CTL), MISC + 8, wave_s * 64 + lane_id());
#endif
    int lo = args.ph_lo; const int hi = args.ph_hi;
#ifndef PHMASK
#define PHMASK 0x1ff
#endif
    if (lo == 0) {
        if (PHMASK & 1) phase_pre(F, args);
        lo = 1;
#if !MK_SPLIT
        if (lo < hi) xcd_barrier(bar, wave_s * 64 + lane_id());
#endif
    }
    for (int ph = lo; ph < hi; ++ph) {
        int bx = blockIdx.x; asm volatile("" : "+s"(bx));
        { unsigned char* wsl = args.ws; asm volatile("" : "+s"(wsl)); F.ws = wsl; }
        {
            const int l = (ph - 1) >> 3, sub = (ph - 1) & 7;
            if (!((PHMASK >> (sub + 1)) & 1)) {}
            else if (sub == 0) { phase_norm(F, args, l); }
            else if (sub == 1 || sub == 5) {
                const int tid = wave_s * 64 + lane_id();
                pg8::APlain ap{(const bf16_t*)(F.ws + WS_H), 1024};
                if (sub == 1) {
                    pg8::StaticOrder S; S.init(T, N_G1A, F.G, bx);
                    EpiG1<0> E{F.ws, ARGIN(args, 14) + (size_t)l * 192, ARGIN(args, 15) + (size_t)l * 192};
                    pg8::gemm_phase<EpiG1<0>, pg8::APlain, pg8::StaticOrder>(F.lds, tid, ap, (const bf16_t*)(F.ws + WS_WIN), 1024, 1024, S, E);
                } else {
                    pg8::StaticOrder S; S.init(T, N_G1B, F.G, bx);
                    EpiG1<1> E{F.ws, nullptr, nullptr};
                    pg8::gemm_phase<EpiG1<1>, pg8::APlain, pg8::StaticOrder>(F.lds, tid, ap, (const bf16_t*)(F.ws + WS_WIN) + (size_t)N_G1A * 1024, 1024, 1024, S, E);
                }
            }
            else if (sub == 2) {
                for (int u = F.vcu; u < 2048 + 1024 + 1536; u += F.G) {
                    if (u < 2048) lru_unit<false>(u, F, args, l);
                    else if (u < 3072) gla1_unit(u - 2048, F, args, l);
                    else att_wave_unit((u - 3072) * 8 + F.wave, F.ws, lane_id());
                }
            }
            else if (sub == 3) {
                for (int u = F.vcu; u < 256 + 4; u += F.G) { if (u < 256) gla2_unit(u, F); else lru2_unit(u - 256, F); }
            }
            else if (sub == 4) {
                for (int u = F.vcu; u < 2048 + 1024 + 256; u += F.G) {
                    if (u < 2048) lru_unit<true>(u, F, args, l);
                    else if (u < 3072) gla3_unit(u - 2048, F, args, l);
                    else yb_unit(u - 3072, F);
                }
            }
            else if (sub == 6) {
                const int tid = wave_s * 64 + lane_id();
                pg8::ASeg3 ap{(const bf16_t*)(F.ws + WS_YA), (const bf16_t*)(F.ws + WS_YB), (const bf16_t*)(F.ws + WS_YC), 1024};
                pg8::StaticOrder S; S.init(T, 1024, F.G, bx);
                EpiG2 E{F.ws};
                pg8::gemm_phase<EpiG2, pg8::ASeg3, pg8::StaticOrder>(F.lds, tid, ap, (const bf16_t*)(F.ws + WS_WP), 2560, 2560, S, E);
            }
            else {
                const int tid = wave_s * 64 + lane_id();
                pg8::APlain ap{(const bf16_t*)(F.ws + WS_MERGED), 1024};
                pg8::StaticOrder S; S.init(T, 1024, F.G, bx);
                EpiG3 E{l == 0 ? ARGIN(args, 0) : args.out, args.out, (const float*)(F.ws + WS_MODF) + (size_t)l * 2 * 3072 + 2048};
                pg8::gemm_phase<EpiG3, pg8::APlain, pg8::StaticOrder>(F.lds, tid, ap, (const bf16_t*)(F.ws + WS_WO), 1024, 1024, S, E);
            }
        }
#if !MK_SPLIT
        if (ph + 1 < hi) xcd_barrier(bar, wave_s * 64 + lane_id());
#endif
    }
}

extern "C" void kernel_launch(void* const* d_in, const int* in_sizes, int n_in, void* d_out, int out_size, void* d_ws, size_t ws_size, hipStream_t stream) {
    static int grid = 0;
    if (grid == 0) {
        if (n_in != 24 || out_size != T * DM || ws_size < WS_END) { fprintf(stderr, "kernel_launch: unexpected shapes (n_in %d, out %d, ws %zu < %zu)\n", n_in, out_size, ws_size, (size_t)WS_END); grid = -1; return; }
        int dev = 0, cus = 0, per_cu = 0;
        if (hipGetDevice(&dev) != hipSuccess || hipDeviceGetAttribute(&cus, hipDeviceAttributeMultiprocessorCount, dev) != hipSuccess) { grid = -1; return; }
        if (hipFuncSetAttribute((const void*)hybrid_fwd, hipFuncAttributeMaxDynamicSharedMemorySize, LDS_BYTES) != hipSuccess) { fprintf(stderr, "kernel_launch: hipFuncSetAttribute failed\n"); grid = -1; return; }
        if (hipOccupancyMaxActiveBlocksPerMultiprocessor(&per_cu, (const void*)hybrid_fwd, NTHR, LDS_BYTES) != hipSuccess || per_cu < 1) { fprintf(stderr, "kernel_launch: occupancy query says %d blocks/CU\n", per_cu); (void)hipGetLastError(); }
        grid = cus;
    }
    if (grid < 0) return;
    (void)hipMemsetAsync((char*)d_ws + WS_CTL, 0, CTL_ZERO_BYTES, stream);
    Args a{};
    for (int i = 0; i < 24; ++i) a.in[i] = (const float*)d_in[i];
    a.out = (float*)d_out; a.ws = (unsigned char*)d_ws;
#if MK_SPLIT
    for (int ph = 0; ph < N_PHASES; ++ph) { a.ph_lo = ph; a.ph_hi = ph + 1; hipLaunchKernelGGL(hybrid_fwd, dim3(grid), dim3(NTHR), LDS_BYTES, stream, a); }
#else
    a.ph_lo = 0; a.ph_hi = N_PHASES;
    hipLaunchKernelGGL(hybrid_fwd, dim3(grid), dim3(NTHR), LDS_BYTES, stream, a);
#endif
}
```

```cpp
#include <hip/hip_runtime.h>
#include <cstdio>
#include <cstdint>

#ifndef MK_SPLIT
#define MK_SPLIT 0
#endif
#ifndef REP
#define REP 0
#endif

#define LAS __attribute__((address_space(3)))
#define GAS __attribute__((address_space(1)))
#define DI __device__ __forceinline__
typedef _Float16 h16x2 __attribute__((ext_vector_type(2)));
typedef unsigned short bf16_t;
typedef short bf16x8 __attribute__((ext_vector_type(8)));
typedef short s16x4 __attribute__((ext_vector_type(4)));
typedef float f32x4 __attribute__((ext_vector_type(4)));
typedef float f32x2 __attribute__((ext_vector_type(2)));
typedef float f32x16 __attribute__((ext_vector_type(16)));
typedef unsigned u32x4 __attribute__((ext_vector_type(4)));
typedef unsigned u32x2 __attribute__((ext_vector_type(2)));
typedef __bf16 bf16x2_t __attribute__((ext_vector_type(2)));

constexpr int BATCH = 2, SEQ = 8192, DM = 1024, T = BATCH * SEQ;
constexpr int N_IN = 13312, N_G1A = 8192, N_G1B = 5120;
constexpr float EPS = 1e-6f;
constexpr float LOG2E = 1.4426950408889634f;

__constant__ float c_invf[32] = {
1.000000000e+00f, 7.498942018e-01f, 5.623413324e-01f, 4.216965139e-01f,
3.162277639e-01f, 2.371373773e-01f, 1.778279394e-01f, 1.333521456e-01f,
1.000000015e-01f, 7.498942316e-02f, 5.623413250e-02f, 4.216964915e-02f,
3.162277490e-02f, 2.371373773e-02f, 1.778279431e-02f, 1.333521400e-02f,
9.999999776e-03f, 7.498942316e-03f, 5.623413250e-03f, 4.216964822e-03f,
3.162277630e-03f, 2.371373819e-03f, 1.778279431e-03f, 1.333521446e-03f,
1.000000047e-03f, 7.498941850e-04f, 5.623413017e-04f, 4.216965172e-04f,
3.162277571e-04f, 2.371373703e-04f, 1.778279402e-04f, 1.333521504e-04f};

DI float bf2f(unsigned short u) { return __uint_as_float(((unsigned)u) << 16); }
DI float bflo(unsigned w) { return __uint_as_float(w << 16); }
DI float bfhi(unsigned w) { return __uint_as_float(w & 0xffff0000u); }
DI unsigned pk2(float lo, float hi) { f32x2 v = {lo, hi}; bf16x2_t b = __builtin_convertvector(v, bf16x2_t); return __builtin_bit_cast(unsigned, b); }
DI unsigned short f2bf(float f) { return (unsigned short)(pk2(f, 0.f) & 0xffffu); }
DI float sigmoidf_(float x) { return __builtin_amdgcn_rcpf(1.0f + __builtin_amdgcn_exp2f(-1.4426950408889634f * x)); }
DI float siluf_(float x) { return x * __builtin_amdgcn_rcpf(1.0f + __builtin_amdgcn_exp2f(-1.4426950408889634f * x)); }
DI int crow(int reg, int h) { return (reg & 3) + 8 * (reg >> 2) + 4 * h; }
#define MFMA32(a, b, c) __builtin_amdgcn_mfma_f32_32x32x16_bf16((a), (b), (c), 0, 0, 0)
DI float shx(float v, int lane, int m) { return __int_as_float(__builtin_amdgcn_ds_bpermute((lane ^ m) << 2, __float_as_int(v))); }
DI float wave_sum(float v, int lane) {
#pragma unroll
    for (int o = 1; o < 64; o <<= 1) v += shx(v, lane, o);
    return v;
}
DI bf16x8 pack_step(const f32x16& x, int s) {
    u32x4 p;
    p[0] = pk2(x[8 * s + 0], x[8 * s + 1]); p[1] = pk2(x[8 * s + 2], x[8 * s + 3]);
    p[2] = pk2(x[8 * s + 4], x[8 * s + 5]); p[3] = pk2(x[8 * s + 6], x[8 * s + 7]);
    return __builtin_bit_cast(bf16x8, p);
}

namespace pg8 {
#define PG8_LAS __attribute__((address_space(3)))
constexpr int BM = 256, BK = 64, HALF = 128, HTB = HALF * BK * 2, STAGE_BYTES = 8 * HTB, NXCD = 8, WGM = 8;
__host__ __device__ __forceinline__ int lds_byte(int r, int c) { const int st = (r >> 4) * 2 + (c >> 5), rr = r & 15, cc = c & 31, ob = rr * 64 + cc * 2; return st * 1024 + (ob ^ (((ob >> 9) & 1) << 5)); }
__host__ __device__ __forceinline__ void stage_rc(int b, int& R, int& C) { const int st = b / 1024, sb = b % 1024, swz = sb ^ (((sb >> 9) & 1) << 5); R = (st >> 1) * 16 + swz / 64; C = (st & 1) * 32 + (swz % 64) / 2; }
__host__ __device__ __forceinline__ int perm32(int rho) { const int n = rho >> 4, i = rho & 15; return 8 * (i >> 2) + 4 * n + (i & 3); }
struct Unit { int pm, pn; };
struct StaticOrder {
    int nM, nN, nwg, G, c;
    __host__ __device__ void init(int M, int N, int G_, int c_) { nM = M / BM; nN = N / BM; nwg = nM * nN; G = G_; c = c_; }
    __host__ __device__ bool next(int i, Unit& u) const {
        const long L = (long)i * G + c; if (L >= nwg) return false;
        int wgid = (int)L; { const int q = nwg / NXCD, r = nwg % NXCD, xcd = wgid % NXCD, off = wgid / NXCD; wgid = (xcd < r ? xcd * (q + 1) : r * (q + 1) + (xcd - r) * q) + off; }
        const int nig = WGM * nN, gid = wgid / nig, fm = gid * WGM, gsz = (nM - fm) < WGM ? (nM - fm) : WGM;
        u.pm = fm + ((wgid % nig) % gsz); u.pn = (wgid % nig) / gsz; return true;
    }
};
struct APlain { const bf16_t* A; int lda;
    DI const char* at(int pm, int t) const { return (const char*)(A + (size_t)pm * 256 * lda + (size_t)t * 64); } };
struct ASeg3 { const bf16_t* A0; const bf16_t* A1; const bf16_t* A2; int lda;
    DI const char* at(int pm, int t) const { const bf16_t* base = t < 16 ? A0 + t * 64 : (t < 24 ? A1 + (t - 16) * 64 : A2 + (t - 24) * 64); return (const char*)(base + (size_t)pm * 256 * lda); } };

template <class Epi, class AP, class Sched>
__device__ __forceinline__ void gemm_phase(PG8_LAS unsigned char* lds, int tid, const AP ap, const bf16_t* Bt, int ldb, int K, const Sched& S, const Epi& E) {
    const int wid = __builtin_amdgcn_readfirstlane(tid >> 6), lane = tid & 63, wr = wid >> 2, wc = wid & 3, fr = lane & 15, fq = lane >> 4;
    const int nt = K / BK, lda = ap.lda;
    unsigned voffA[2], voffB[2];
#pragma unroll
    for (int i = 0; i < 2; ++i) { int R, C; stage_rc(tid * 16 + i * 8192, R, C); const int Rb = Epi::PERM ? ((R & ~31) + perm32(R & 31)) : R;
        voffA[i] = (unsigned)(R * lda + C) * 2u; voffB[i] = (unsigned)(Rb * ldb + C) * 2u; }
    const size_t kstep = (size_t)(BK * 2);
    const size_t hstepA = (size_t)HALF * lda * 2, hstepB = (size_t)HALF * ldb * 2;
    const size_t tstepB = 2 * hstepB;
    const unsigned ldsw = (unsigned)wid * 1024u;
    const int aoff = lds_byte(wr * 64 + fr, fq * 8), boff = lds_byte(wc * 32 + fr, fq * 8);
#define PG8_SA(b, h) (((b) * 2 + (h)) * HTB)
#define PG8_SB(b, h) ((4 + (b) * 2 + (h)) * HTB)
#define PG8_STAGE(bufoff, gbase, voff) do { _Pragma("unroll") for (int _i = 0; _i < 2; ++_i) \
        __builtin_amdgcn_global_load_lds((const unsigned*)((const char*)(gbase) + (voff)[_i]), (PG8_LAS unsigned*)(lds + (bufoff) + ldsw + _i * 8192), 16, 0, 0); } while (0)
#define PG8_LDA(dst, b, h) do { _Pragma("unroll") for (int m = 0; m < 4; ++m) _Pragma("unroll") for (int k = 0; k < 2; ++k) dst[m][k] = *(const PG8_LAS bf16x8*)(lds + PG8_SA(b, h) + aoff + m * 2048 + k * 1024); } while (0)
#define PG8_LDB(dst, b, h) do { _Pragma("unroll") for (int n = 0; n < 2; ++n) _Pragma("unroll") for (int k = 0; k < 2; ++k) dst[n][k] = *(const PG8_LAS bf16x8*)(lds + PG8_SB(b, h) + boff + n * 2048 + k * 1024); } while (0)
#define PG8_MMA(ai, bj, At, Bt_) do { asm volatile(".p2align 3\n\ts_nop 0\n\ts_setprio 1" ::: "memory"); _Pragma("unroll") for (int m = 0; m < 4; ++m) _Pragma("unroll") for (int n = 0; n < 2; ++n) _Pragma("unroll") for (int k = 0; k < 2; ++k) \
        acc[ai][bj][m][n] = __builtin_amdgcn_mfma_f32_16x16x32_bf16(Bt_[n][k], At[m][k], acc[ai][bj][m][n], 0, 0, 0); __builtin_amdgcn_s_setprio(0); } while (0)
#define PG8_WAIT_V(n) asm volatile("s_waitcnt vmcnt(" #n ")" ::: "memory")
#define PG8_WAIT_L(n) asm volatile("s_waitcnt lgkmcnt(" #n ")" ::: "memory")
#define PG8_BAR __builtin_amdgcn_s_barrier()
#define PG8_SCHED __builtin_amdgcn_sched_barrier(0)
    Unit cur, nxt; int ui = 0;
    if (!S.next(0, cur)) return;
    f32x4 acc[2][2][4][2];
#pragma unroll
    for (int a = 0; a < 2; ++a)
#pragma unroll
        for (int b = 0; b < 2; ++b)
#pragma unroll
            for (int m = 0; m < 4; ++m)
#pragma unroll
                for (int n = 0; n < 2; ++n) acc[a][b][m][n] = (f32x4){0.f, 0.f, 0.f, 0.f};
    bf16x8 At[4][2], B0[2][2], B1[2][2];
    const char* cB = (const char*)Bt + (size_t)cur.pn * tstepB;
    {
        const char* cA0 = ap.at(cur.pm, 0); const char* cA1 = ap.at(cur.pm, 1);
        PG8_STAGE(PG8_SB(0, 0), cB, voffB); PG8_STAGE(PG8_SB(0, 1), cB + hstepB, voffB); PG8_STAGE(PG8_SA(0, 0), cA0, voffA); PG8_STAGE(PG8_SA(0, 1), cA0 + hstepA, voffA);
        if (wr == 1) PG8_BAR;
        PG8_WAIT_V(2); PG8_BAR;
        PG8_STAGE(PG8_SB(1, 0), cB + kstep, voffB); PG8_STAGE(PG8_SA(1, 0), cA1, voffA); PG8_STAGE(PG8_SB(1, 1), cB + hstepB + kstep, voffB);
        PG8_WAIT_V(6); PG8_BAR;
    }
    for (;;) {
        const bool has_next = S.next(ui + 1, nxt);
        const Unit nu = has_next ? nxt : cur;
        const char* nB = (const char*)Bt + (size_t)nu.pn * tstepB;
        for (int t = 0; t < nt; t += 2) {
            const bool last = (t == nt - 2);
            asm volatile("" : "+v"(voffA[0]), "+v"(voffA[1]), "+v"(voffB[0]), "+v"(voffB[1]));
            if constexpr (Epi::KHOOK) { E.khook(acc, cur, t, wr, wc, fr, fq); PG8_SCHED; }
            const char* a1 = ap.at(cur.pm, t + 1);
            const char* a2 = last ? ap.at(nu.pm, 0) : ap.at(cur.pm, t + 2);
            const char* a3 = last ? ap.at(nu.pm, 1) : ap.at(cur.pm, t + 3);
            const char* b2 = last ? nB : cB + (size_t)(t + 2) * kstep;
            const char* b3 = b2 + kstep;
            PG8_LDB(B0, 0, 0); PG8_LDB(B1, 0, 1); PG8_SCHED; PG8_LDA(At, 0, 0); PG8_STAGE(PG8_SA(1, 1), a1 + hstepA, voffA);
            PG8_WAIT_V(8); PG8_WAIT_L(0); PG8_BAR; PG8_MMA(0, 0, At, B0); PG8_MMA(0, 1, At, B1); PG8_BAR; PG8_SCHED;
            PG8_LDA(At, 0, 1); PG8_STAGE(PG8_SB(0, 0), b2, voffB); PG8_STAGE(PG8_SB(0, 1), b2 + hstepB, voffB); PG8_STAGE(PG8_SA(0, 0), a2, voffA);
            PG8_WAIT_V(8); PG8_WAIT_L(0); PG8_BAR; PG8_MMA(1, 0, At, B0); PG8_MMA(1, 1, At, B1); PG8_BAR; PG8_SCHED;
            PG8_LDB(B0, 1, 0); PG8_LDB(B1, 1, 1); PG8_SCHED; PG8_LDA(At, 1, 0); PG8_STAGE(PG8_SA(0, 1), a2 + hstepA, voffA);
            PG8_WAIT_V(8); PG8_WAIT_L(0); PG8_BAR; PG8_MMA(0, 0, At, B0); PG8_MMA(0, 1, At, B1); PG8_BAR; PG8_SCHED;
            PG8_LDA(At, 1, 1); PG8_STAGE(PG8_SB(1, 0), b3, voffB); PG8_STAGE(PG8_SB(1, 1), b3 + hstepB, voffB); PG8_STAGE(PG8_SA(1, 0), a3, voffA);
            PG8_WAIT_V(8); PG8_WAIT_L(0); PG8_BAR; PG8_MMA(1, 0, At, B0); PG8_MMA(1, 1, At, B1); PG8_BAR; PG8_SCHED;
        }
        if (wr == 0) PG8_BAR;
        E(acc, cur, wr, wc, fr, fq);
        if (!has_next) break;
#pragma unroll
        for (int a = 0; a < 2; ++a)
#pragma unroll
            for (int b = 0; b < 2; ++b)
#pragma unroll
                for (int m = 0; m < 4; ++m)
#pragma unroll
                    for (int n = 0; n < 2; ++n) acc[a][b][m][n] = (f32x4){0.f, 0.f, 0.f, 0.f};
        cur = nxt; cB = nB; ++ui;
        if (wr == 1) PG8_BAR;
    }
    PG8_WAIT_V(0);
    PG8_BAR;
#undef PG8_SA
#undef PG8_SB
#undef PG8_STAGE
#undef PG8_LDA
#undef PG8_LDB
#undef PG8_MMA
#undef PG8_WAIT_V
#undef PG8_WAIT_L
#undef PG8_BAR
#undef PG8_SCHED
}
}

constexpr size_t MiB = 1u << 20;
constexpr size_t WS_CTL = 0, CTL_ZERO_BYTES = 64 * 1024;
constexpr size_t WS_MODF = 1 * MiB;
constexpr size_t WS_MODP = WS_MODF + 64 * 1024;
constexpr size_t WS_LRUW = 2 * MiB;
constexpr size_t WS_GDEC = WS_LRUW + 256 * 1024;
constexpr size_t WS_LR   = 3 * MiB;
constexpr size_t WS_ROPE = 4 * MiB;
constexpr size_t WS_LSE  = 8 * MiB;
constexpr size_t WS_LA   = 10 * MiB;
constexpr size_t WS_LH   = 11 * MiB;
constexpr size_t WS_LC   = 12 * MiB;
constexpr size_t WS_WO   = 13 * MiB;
constexpr size_t WS_WP   = 15 * MiB;
constexpr size_t WS_WIN  = 20 * MiB;
constexpr size_t WS_H    = 46 * MiB;
constexpr size_t WS_AX   = 78 * MiB;
constexpr size_t WS_Q    = 110 * MiB;
constexpr size_t WS_K    = 158 * MiB;
constexpr size_t WS_VT   = 206 * MiB;
constexpr size_t WS_CQ   = 254 * MiB;
constexpr size_t WS_CK   = 270 * MiB;
constexpr size_t WS_CV   = 286 * MiB;
constexpr size_t WS_YA   = 318 * MiB;
constexpr size_t WS_KV   = 350 * MiB;
constexpr size_t WS_END  = 414 * MiB;
constexpr size_t WS_MG = WS_Q, WS_YB = WS_VT, WS_MERGED = WS_AX, WS_YC = WS_CV;
constexpr size_t WS_BG = WS_KV + 32 * MiB;
constexpr size_t WS_ACUM = WS_KV + 48 * MiB;

constexpr int RING_BYTES = 131072, LDSCTL_OFF = RING_BYTES, MISC_OFF = LDSCTL_OFF + 320, LDS_BYTES = 147456;
constexpr int NWAVES = 8, NTHR = 512;

typedef GAS unsigned gu32;
#define RLX_AGENT __ATOMIC_RELAXED, __HIP_MEMORY_SCOPE_AGENT
#define XB_TMO      128
#define XB_XCNT(j)  (256  + 64 * (j))
#define XB_XSUB(j)  (1280 + 64 * (j))
#define XB_XGEN(j)  (2304 + 64 * (j))
#define XB_TOP      3328
#define XB_TOPGEN   3392
#define XCD_BAR_WORDS 3456
#define XB_SPIN_CAP (1u << 18)
DI unsigned xb_ld(unsigned* p)              { return __hip_atomic_load(p, __ATOMIC_RELAXED, __HIP_MEMORY_SCOPE_AGENT); }
DI unsigned xb_add(unsigned* p, unsigned v) { return __hip_atomic_fetch_add(p, v, __ATOMIC_RELAXED, __HIP_MEMORY_SCOPE_AGENT); }
DI unsigned xb_xcc_id() { return (unsigned)__builtin_amdgcn_s_getreg((3 << 11) | 20) & 0xFu; }
#define XB_SPIN(cond, bar) do { unsigned _sp = 0; while (cond) { __builtin_amdgcn_s_sleep(1); \
    if ((++_sp & 255u) == 0u) { if (xb_ld(&(bar)[XB_TMO])) break; if (_sp > XB_SPIN_CAP) { atomicAdd(&(bar)[XB_TMO], 1u); break; } } } } while (0)
struct XcdBarrier { unsigned* bar; unsigned x; volatile LAS unsigned* st; };
DI XcdBarrier xcd_barrier_post(unsigned* bar, volatile LAS unsigned* st, int tid) {
    XcdBarrier b; b.bar = bar; b.x = xb_xcc_id(); b.st = st;
    if (tid == 0) (void)xb_add(&bar[XB_XCNT(b.x)], 1u);
    return b;
}
DI void xcd_barrier_complete(unsigned* bar, unsigned x, unsigned& nloc, unsigned& nx) {
    const unsigned G = gridDim.x * gridDim.y * gridDim.z;
    unsigned sum, cnt, mine, sp = 0u;
    for (;;) {
        sum = 0u; cnt = 0u; mine = 0u;
#pragma unroll
        for (unsigned j = 0; j < 16; ++j) { const unsigned c = xb_ld(&bar[XB_XCNT(j)]); sum += c; cnt += (c > 0u) ? 1u : 0u; mine = (j == x) ? c : mine; }
        if (sum == G) break;
        __builtin_amdgcn_s_sleep(1);
        if ((++sp & 255u) == 0u) { if (xb_ld(&bar[XB_TMO])) break; if (sp > XB_SPIN_CAP) { atomicAdd(&bar[XB_TMO], 1u); break; } }
    }
    nloc = mine > 0u ? mine : 1u; nx = cnt > 0u ? cnt : 1u;
}
DI void xcd_barrier(const XcdBarrier& b, int tid) {
    asm volatile("s_waitcnt vmcnt(0)" ::: "memory");
    __syncthreads();
    if (tid == 0) {
        unsigned* bar = b.bar;
        __builtin_amdgcn_s_waitcnt(0);
        unsigned nloc = b.st[0], nx = b.st[1];
        if (nloc == 0u) { xcd_barrier_complete(bar, b.x, nloc, nx); b.st[0] = nloc; b.st[1] = nx; }
        const unsigned old = xb_add(&bar[XB_XSUB(b.x)], 1u);
        const unsigned gen = old / nloc;
        if (old + 1u == (gen + 1u) * nloc) {
            __builtin_amdgcn_fence(__ATOMIC_RELEASE, "agent");
            asm volatile("s_waitcnt vmcnt(0)" ::: "memory");
            const unsigned og = xb_add(&bar[XB_TOP], 1u);
            const unsigned tg = og / nx;
            if (og + 1u == (tg + 1u) * nx) xb_add(&bar[XB_TOPGEN], 1u);
            else XB_SPIN(xb_ld(&bar[XB_TOPGEN]) == tg, bar);
            __builtin_amdgcn_fence(__ATOMIC_ACQUIRE, "agent");
            xb_add(&bar[XB_XGEN(b.x)], 1u);
            asm volatile("s_waitcnt vmcnt(0)" ::: "memory");
        } else {
            XB_SPIN(xb_ld(&bar[XB_XGEN(b.x)]) == gen, bar);
            __builtin_amdgcn_fence(__ATOMIC_ACQUIRE, "agent");
            asm volatile("s_waitcnt vmcnt(0)" ::: "memory");
        }
    }
    __syncthreads();
}

struct Args { const float* in[24]; float* out; unsigned char* ws; int ph_lo, ph_hi; };
#define ARGIN(A, i) ([&]() -> const float* { int _i = (i); asm volatile("" : "+s"(_i)); return (const float*)(const GAS float*)(A).in[_i]; }())
#define ARGOUT(A) ((float*)(GAS float*)(A).out)
struct Frame {
    LAS unsigned char* lds;
    int wave, vcu, G;
    GAS unsigned char* ws;
};
DI int lane_id() { int l; asm volatile("v_mbcnt_lo_u32_b32 %0, -1, 0\n\tv_mbcnt_hi_u32_b32 %0, -1, %0" : "=v"(l)); return l; }
#define FRAME_LT const int lane = lane_id(); const int tid = F.wave * 64 + lane; (void)tid; (void)lane

DI void phase_pre(const Frame& F, const Args& a) {
    FRAME_LT;
    const int* pos = (const int*)ARGIN(a, 2);
    h16x2* rope = (h16x2*)(F.ws + WS_ROPE);
    const int gt = F.vcu * NTHR + tid, GT = F.G * NTHR;
    for (int i = gt; i < T * 32; i += GT) {
        const int m = i >> 5, fi = i & 31;
        const float angf = (float)pos[m] * c_invf[fi];
        const double ang = (double)angf;
        const double kq = __builtin_rint(ang * 0.63661977236758134308);
        const double y = (ang - kq * 1.5707963267948966192) - kq * 6.123233995736766e-17;
        const double y2 = y * y;
        double sn = y * (1.0 + y2 * (-1.0 / 6 + y2 * (1.0 / 120 + y2 * (-1.0 / 5040 + y2 * (1.0 / 362880 + y2 * (-1.0 / 39916800 + y2 * (1.0 / 6227020800.0)))))));
        double cs = 1.0 + y2 * (-0.5 + y2 * (1.0 / 24 + y2 * (-1.0 / 720 + y2 * (1.0 / 40320 + y2 * (-1.0 / 3628800 + y2 * (1.0 / 479001600.0))))));
        const int q = ((int)kq) & 3;
        double c, s;
        if (q == 0) { c = cs; s = sn; } else if (q == 1) { c = -sn; s = cs; } else if (q == 2) { c = -cs; s = -sn; } else { c = sn; s = -cs; }
        rope[i] = (h16x2){(_Float16)(float)c, (_Float16)(float)s};
    }
    const float* cvec = ARGIN(a, 1); const float* ada_w = ARGIN(a, 3);
    float* modp = (float*)(F.ws + WS_MODP);
    for (int i = gt; i < 16 * 2 * 3072; i += GT) {
        const int j = i % 3072, l = (i / 3072) & 1, sl = i / 6144;
        float a0 = 0.f, a1 = 0.f;
        const float* w = ada_w + ((size_t)l * DM + sl * 64) * 3072 + j;
#pragma unroll 8
        for (int c = 0; c < 64; ++c) { const float wv = w[(size_t)c * 3072]; a0 += siluf_(cvec[sl * 64 + c]) * wv; a1 += siluf_(cvec[DM + sl * 64 + c]) * wv; }
        modp[((sl * 2 + l) * 2 + 0) * 3072 + j] = a0; modp[((sl * 2 + l) * 2 + 1) * 3072 + j] = a1;
    }
}

DI void convert_item(const float* Wcol, int ldw, bf16_t* drow, float scale = 1.0f) {
    float v[32];
#pragma unroll
    for (int kk = 0; kk < 32; ++kk) v[kk] = Wcol[(size_t)kk * ldw] * scale;
#pragma unroll
    for (int j = 0; j < 4; ++j) { u32x4 o; o.x = pk2(v[8 * j], v[8 * j + 1]); o.y = pk2(v[8 * j + 2], v[8 * j + 3]); o.z = pk2(v[8 * j + 4], v[8 * j + 5]); o.w = pk2(v[8 * j + 6], v[8 * j + 7]);
        *(u32x4*)(drow + 8 * j) = o; }
}
DI int win_dst_row(int n) {
    if (n < 1024) return n;
    if (n < 2048) return 8192 + (n - 1024);
    if (n < 5120) {
        const int isk = n >= 3584; const int x = n - (isk ? 3584 : 2048);
        const int tl = x >> 8, L = x & 255, wc = L >> 6, bj = (L >> 5) & 1, r = L & 31;
        return (isk ? 2560 : 1024) + tl * 256 + 128 * bj + 32 * wc + r;
    }
    if (n < 6656) return 4096 + (n - 5120);
    if (n < 7168) return 7680 + (n - 6656);
    if (n < 7680) return 5632 + (n - 7168);
    if (n < 8192) return 6144 + (n - 7680);
    if (n < 9216) return 6656 + (n - 8192);
    if (n < 10240) return 9216 + (n - 9216);
    return n;
}
DI void phase_norm(const Frame& F, const Args& a, int l) {
    FRAME_LT;
    {
        const int gw = F.vcu * NWAVES + F.wave, NGW = F.G * NWAVES;
        const float* w_in = ARGIN(a, 6) + (size_t)l * DM * N_IN;
        const float* proj_a = ARGIN(a, 20) + (size_t)l * 1024 * 1024;
        const float* proj_b = ARGIN(a, 21) + (size_t)l * 512 * 1024;
        const float* proj_c = ARGIN(a, 22) + (size_t)l * 1024 * 1024;
        const float* w_o = ARGIN(a, 23) + (size_t)l * 1024 * 1024;
        const float* lru_wa = ARGIN(a, 9) + (size_t)l * 16 * 64 * 64;
        const float* lru_wx = ARGIN(a, 11) + (size_t)l * 16 * 64 * 64;
        bf16_t* WIN = (bf16_t*)(F.ws + WS_WIN); bf16_t* WP = (bf16_t*)(F.ws + WS_WP); bf16_t* WO = (bf16_t*)(F.ws + WS_WO); bf16_t* LW = (bf16_t*)(F.ws + WS_LRUW);
        constexpr int I_IN = 32 * 208, I_PA = 32 * 16, I_PB = 16 * 16, I_PC = 32 * 16, I_WO = 32 * 16, I_LW = 64;
        constexpr int NITEMS = I_IN + I_PA + I_PB + I_PC + I_WO + I_LW;
        for (int it = gw; it < NITEMS; it += NGW) {
            int r = it;
            if (r < I_IN) { const int kb = r / 208, n = 64 * (r % 208) + lane; convert_item(w_in + (size_t)(32 * kb) * N_IN + n, N_IN, WIN + (size_t)win_dst_row(n) * 1024 + 32 * kb); continue; } r -= I_IN;
            if (r < I_PA) { const int kb = r / 16, n = 64 * (r % 16) + lane; convert_item(proj_a + (size_t)(32 * kb) * 1024 + n, 1024, WP + (size_t)n * 2560 + 32 * kb); continue; } r -= I_PA;
            if (r < I_PB) { const int kb = r / 16, n = 64 * (r % 16) + lane; convert_item(proj_b + (size_t)(32 * kb) * 1024 + n, 1024, WP + (size_t)n * 2560 + 1024 + 32 * kb); continue; } r -= I_PB;
            if (r < I_PC) { const int kb = r / 16, n = 64 * (r % 16) + lane; convert_item(proj_c + (size_t)(32 * kb) * 1024 + n, 1024, WP + (size_t)n * 2560 + 1536 + 32 * kb); continue; } r -= I_PC;
            if (r < I_WO) { const int kb = r / 16, n = 64 * (r % 16) + lane; convert_item(w_o + (size_t)(32 * kb) * 1024 + n, 1024, WO + (size_t)n * 1024 + 32 * kb); continue; } r -= I_WO;
            { const int mat = r >> 1, jb = r & 1, blk = mat >> 1, gate = mat & 1;
              const float* src = (gate ? lru_wx : lru_wa) + (size_t)blk * 4096;
              convert_item(src + (size_t)(32 * jb) * 64 + lane, 64, LW + (size_t)(blk * 2 + gate) * 4096 + (size_t)lane * 64 + 32 * jb, -LOG2E); }
        }
    }
    __syncthreads();
    LAS float* sh = (LAS float*)(F.lds);
    LAS float* sc = (LAS float*)(F.lds + 8192);
    LAS float* a1T = (LAS float*)(F.lds + 16384);
    {
        const float* modp = (const float*)(F.ws + WS_MODP); const float* ada_b = ARGIN(a, 4) + (size_t)l * 3072;
        float* modf = (float*)(F.ws + WS_MODF);
        for (int i = tid; i < 2 * 2048; i += NTHR) {
            const int b = i >> 11, j = i & 2047; float s = ada_b[j];
#pragma unroll
            for (int sl = 0; sl < 16; ++sl) s += modp[((sl * 2 + l) * 2 + b) * 3072 + j];
            if (j < 1024) sh[b * 1024 + j] = s; else sc[b * 1024 + (j - 1024)] = s;
        }
        const int gt = F.vcu * NTHR + tid;
        if (gt < 2 * 3072) { const int b = gt / 3072, j = gt % 3072; float s = ada_b[j];
#pragma unroll
            for (int sl = 0; sl < 16; ++sl) s += modp[((sl * 2 + l) * 2 + b) * 3072 + j];
            modf[(l * 2 + b) * 3072 + j] = s; }
        const float* a1 = ARGIN(a, 16) + (size_t)l * 1024 * 16;
        for (int i = tid; i < 16384; i += NTHR) { const int c = i >> 4, r = i & 15; a1T[r * 1024 + c] = a1[i]; }
    }
    __syncthreads();
    {
        const float* xin = l == 0 ? ARGIN(a, 0) : (const float*)ARGOUT(a);
        const float* ng = ARGIN(a, 5) + (size_t)l * 1024;
        bf16_t* H = (bf16_t*)(F.ws + WS_H); float* LR = (float*)(F.ws + WS_LR);
        const int gw = F.vcu * NWAVES + F.wave, NGW = F.G * NWAVES;
        f32x4 gv[4];
#pragma unroll
        for (int j = 0; j < 4; ++j) gv[j] = *(const f32x4*)(ng + 4 * lane + 256 * j);
        f32x4 nv[4];
        if (gw < T) { const f32x4* xr = (const f32x4*)(xin + (size_t)gw * DM) + lane;
#pragma unroll
            for (int j = 0; j < 4; ++j) nv[j] = xr[64 * j]; }
        for (int m = gw; m < T; m += NGW) {
            const int b = m >> 13;
            f32x4 v[4]; float ss = 0.f;
#pragma unroll
            for (int j = 0; j < 4; ++j) { v[j] = nv[j]; ss += (v[j].x * v[j].x + v[j].y * v[j].y) + (v[j].z * v[j].z + v[j].w * v[j].w); }
            if (m + NGW < T) { const f32x4* xr = (const f32x4*)(xin + (size_t)(m + NGW) * DM) + lane;
#pragma unroll
                for (int j = 0; j < 4; ++j) nv[j] = xr[64 * j]; }
            const float rinv = 1.0f / sqrtf(wave_sum(ss, lane) * (1.f / DM) + EPS);
            float lr[16];
#pragma unroll
            for (int r = 0; r < 16; ++r) lr[r] = 0.f;
            unsigned long long* o8 = (unsigned long long*)(H + (size_t)m * DM) + lane;
#pragma unroll
            for (int j = 0; j < 4; ++j) {
                const int c0 = 4 * lane + 256 * j;
                const f32x4 scv = *(const LAS f32x4*)(sc + b * 1024 + c0), shv = *(const LAS f32x4*)(sh + b * 1024 + c0);
                f32x4 hv;
#pragma unroll
                for (int e = 0; e < 4; ++e) hv[e] = v[j][e] * rinv * gv[j][e] * (1.0f + scv[e]) + shv[e];
                o8[64 * j] = (unsigned long long)pk2(hv.x, hv.y) | ((unsigned long long)pk2(hv.z, hv.w) << 32);
#pragma unroll
                for (int r = 0; r < 16; ++r) { const f32x4 av = *(const LAS f32x4*)(a1T + r * 1024 + c0); lr[r] += (hv.x * av.x + hv.y * av.y) + (hv.z * av.z + hv.w * av.w);
                    if ((r & 3) == 3) asm volatile("" ::: "memory"); }
            }
            float a8[8], a4[4], a2[2], a1v;
            { const bool up = (lane & 32) != 0;
#pragma unroll
              for (int r = 0; r < 8; ++r) { const float keep = up ? lr[r + 8] : lr[r], send = up ? lr[r] : lr[r + 8]; a8[r] = keep + shx(send, lane, 32); } }
            { const bool up = (lane & 16) != 0;
#pragma unroll
              for (int r = 0; r < 4; ++r) { const float keep = up ? a8[r + 4] : a8[r], send = up ? a8[r] : a8[r + 4]; a4[r] = keep + shx(send, lane, 16); } }
            { const bool up = (lane & 8) != 0;
#pragma unroll
              for (int r = 0; r < 2; ++r) { const float keep = up ? a4[r + 2] : a4[r], send = up ? a4[r] : a4[r + 2]; a2[r] = keep + shx(send, lane, 8); } }
            { const bool up = (lane & 4) != 0; const float keep = up ? a2[1] : a2[0], send = up ? a2[0] : a2[1]; a1v = keep + shx(send, lane, 4); }
            a1v += shx(a1v, lane, 2); a1v += shx(a1v, lane, 1);
            if ((lane & 3) == 0) LR[(size_t)m * 16 + (lane >> 2)] = a1v;
        }
    }
}

template <int mode> struct EpiG1 {
    static constexpr bool PERM = true, KHOOK = false;
    bool dry;
    GAS unsigned char* ws; const float* qn_g; const float* kn_g;
    DI void store_plain(const f32x4 (&acc)[2][2][4][2], bf16_t* base, int ldc, int col0, int row0, float sc) const {
#pragma unroll
        for (int ai = 0; ai < 2; ++ai)
#pragma unroll
            for (int m = 0; m < 4; ++m) { bf16_t* rowp = base + (size_t)(row0 + ai * 128 + m * 16) * ldc + col0;
#pragma unroll
                for (int bj = 0; bj < 2; ++bj) { const f32x4 v0 = acc[ai][bj][m][0] * sc, v1 = acc[ai][bj][m][1] * sc;
                    u32x4 w; w.x = pk2(v0[0], v0[1]); w.y = pk2(v0[2], v0[3]); w.z = pk2(v1[0], v1[1]); w.w = pk2(v1[2], v1[3]);
                    *(u32x4*)(rowp + bj * 128) = w; } }
    }
    DI void operator()(f32x4 (&acc)[2][2][4][2], const pg8::Unit& u, int wr, int wc, int, int) const {
        const int ln_ = lane_id(), fr = ln_ & 15, fq = ln_ >> 4;
        const int pn = u.pn, row0 = u.pm * 256 + wr * 64 + fr, cw = wc * 32 + 8 * fq;
        if (mode == 0) {
            if (pn < 4) { store_plain(acc, (bf16_t*)(ws + WS_AX), 1024, pn * 256 + cw, row0, 1.0f); }
            else if (pn < 16) {
                const bool isk = pn >= 10; const int t6 = pn - (isk ? 10 : 4), g = t6 >> 1;
                bf16_t* base = (bf16_t*)(ws + (isk ? WS_K : WS_Q));
                const float* gn = (isk ? kn_g : qn_g) + g * 64;
                const float sc = isk ? 1.0f : 0.125f * LOG2E;
                const u32x4* rope = (const u32x4*)(ws + WS_ROPE);
                u32x4 rp[2][4][2];
#pragma unroll
                for (int m = 0; m < 4; ++m) { const u32x4* p = rope + (size_t)(row0 + m * 16) * 8 + 2 * fq; rp[0][m][0] = p[0]; rp[0][m][1] = p[1]; }
                f32x4 g0[2], g1[2];
#pragma unroll
                for (int n = 0; n < 2; ++n) { g0[n] = *(const f32x4*)(gn + 8 * fq + 4 * n); g1[n] = *(const f32x4*)(gn + 32 + 8 * fq + 4 * n); }
#pragma unroll
                for (int ai = 0; ai < 2; ++ai)
#pragma unroll
                    for (int m = 0; m < 4; ++m) {
                        const int row = row0 + ai * 128 + m * 16;
                        if (ai == 0) { const u32x4* p = rope + (size_t)(row + 128) * 8 + 2 * fq; rp[1][m][0] = p[0]; rp[1][m][1] = p[1]; }
                        float ss = 0.f;
#pragma unroll
                        for (int bj = 0; bj < 2; ++bj)
#pragma unroll
                            for (int n = 0; n < 2; ++n) { const f32x4 x = acc[ai][bj][m][n]; ss += (x[0] * x[0] + x[1] * x[1]) + (x[2] * x[2] + x[3] * x[3]); }
                        ss += shx(ss, fq * 16 + fr, 16); ss += shx(ss, fq * 16 + fr, 32);
                        const float rinv = __builtin_amdgcn_rsqf(ss * (1.f / 64.f) + EPS) * sc;
                        u32x4 w1, w2;
#pragma unroll
                        for (int n = 0; n < 2; ++n) {
                            const u32x4 cw4 = rp[ai][m][n];
                            const f32x4 y1 = acc[ai][0][m][n] * rinv * g0[n], y2 = acc[ai][1][m][n] * rinv * g1[n];
                            float a[4], b[4];
#pragma unroll
                            for (int e = 0; e < 4; ++e) { const unsigned wv = cw4[e]; const h16x2 cs = __builtin_bit_cast(h16x2, wv);   const float c = (float)cs[0], sn = (float)cs[1];
                                a[e] = y1[e] * c - y2[e] * sn; b[e] = y2[e] * c + y1[e] * sn; }
                            w1[2 * n] = pk2(a[0], a[1]); w1[2 * n + 1] = pk2(a[2], a[3]); w2[2 * n] = pk2(b[0], b[1]); w2[2 * n + 1] = pk2(b[2], b[3]);
                        }
                        bf16_t* rowp = base + (size_t)row * 1536 + t6 * 256 + 64 * wc + 8 * fq;
                        *(u32x4*)(rowp) = w1; *(u32x4*)(rowp + 32) = w2;
                        asm volatile("" ::: "memory");
                    }
            }
            else if (pn < 22) { store_plain(acc, (bf16_t*)(ws + WS_VT), 1536, (pn - 16) * 256 + cw, row0, 1.0f); }
            else if (pn < 24) { store_plain(acc, (bf16_t*)(ws + WS_CQ), 512, (pn - 22) * 256 + cw, row0, 0.08838834764831845f); }
            else if (pn < 26) { store_plain(acc, (bf16_t*)(ws + WS_CK), 512, (pn - 24) * 256 + cw, row0, 1.0f); }
            else if (pn < 30) { store_plain(acc, (bf16_t*)(ws + WS_CV), 1024, (pn - 26) * 256 + cw, row0, 1.0f); }
            else {
                bf16_t* BG = (bf16_t*)(ws + WS_BG); const int col0 = (pn - 30) * 256 + cw;
#pragma unroll
                for (int ai = 0; ai < 2; ++ai)
#pragma unroll
                    for (int m = 0; m < 4; ++m) { bf16_t* rowp = BG + (size_t)(row0 + ai * 128 + m * 16) * 512 + col0;
#pragma unroll
                        for (int bj = 0; bj < 2; ++bj) { const f32x4 v0 = acc[ai][bj][m][0], v1 = acc[ai][bj][m][1];
                            u32x4 w; w.x = pk2(siluf_(v0[0]), siluf_(v0[1])); w.y = pk2(siluf_(v0[2]), siluf_(v0[3])); w.z = pk2(siluf_(v1[0]), siluf_(v1[1])); w.w = pk2(siluf_(v1[2]), siluf_(v1[3]));
                            *(u32x4*)(rowp + bj * 128) = w; } }
            }
        } else {
            if (pn < 8) {
                bf16_t* Y; int col0;
                if (pn < 4) { Y = (bf16_t*)(ws + WS_YA); col0 = pn * 256; } else { Y = (bf16_t*)(ws + WS_YC); col0 = (pn - 4) * 256; }
                const bool isa = pn < 4;
#pragma unroll
                for (int ai = 0; ai < 2; ++ai)
#pragma unroll
                    for (int bj = 0; bj < 2; ++bj)
#pragma unroll
                        for (int m = 0; m < 4; ++m)
#pragma unroll
                            for (int n = 0; n < 2; ++n) asm volatile("" : "+v"(acc[ai][bj][m][n]));
                const unsigned char* AC = (const unsigned char*)(ws + WS_ACUM);
                const float* LC = (const float*)(ws + WS_LC);
                u32x4 yv[8][2]; u32x2 av[8][2]; f32x4 lc[2][2][2];
                auto ld_item = [&](int i) { const size_t ro = (size_t)(row0 + (i >> 2) * 128 + (i & 3) * 16) * 1024 + col0 + cw;
#pragma unroll
                    for (int bj = 0; bj < 2; ++bj) { yv[i][bj] = *(const u32x4*)(Y + ro + bj * 128); av[i][bj] = isa ? *(const u32x2*)(AC + ro + bj * 128) : (u32x2){0u, 0u}; } };
                auto ld_lc = [&](int ai) {
#pragma unroll
                    for (int bj = 0; bj < 2; ++bj)
#pragma unroll
                        for (int n = 0; n < 2; ++n) lc[ai][bj][n] = isa ? *(const f32x4*)(LC + (size_t)(u.pm * 4 + ai * 2 + wr) * 1024 + col0 + cw + bj * 128 + 4 * n) * (1.0f / 255.0f) : (f32x4){0.f, 0.f, 0.f, 0.f}; };
                ld_lc(0); ld_item(0); ld_item(1);
#pragma unroll
                for (int i = 0; i < 8; ++i) { const int ai = i >> 2, m = i & 3; const size_t ro = (size_t)(row0 + ai * 128 + m * 16) * 1024 + col0 + cw;
                    if (i + 2 < 8) ld_item(i + 2);
                    if (i == 2) ld_lc(1);
#pragma unroll
                    for (int bj = 0; bj < 2; ++bj) { const u32x4 y = yv[i][bj]; const u32x2 q = av[i][bj]; const f32x4 v0 = acc[ai][bj][m][0], v1 = acc[ai][bj][m][1], c0 = lc[ai][bj][0], c1 = lc[ai][bj][1];
                        u32x4 w;
                        w.x = pk2((bflo(y.x) + (float)(q.x & 255u) * c0[0]) * siluf_(v0[0]), (bfhi(y.x) + (float)((q.x >> 8) & 255u) * c0[1]) * siluf_(v0[1]));
                        w.y = pk2((bflo(y.y) + (float)((q.x >> 16) & 255u) * c0[2]) * siluf_(v0[2]), (bfhi(y.y) + (float)(q.x >> 24) * c0[3]) * siluf_(v0[3]));
                        w.z = pk2((bflo(y.z) + (float)(q.y & 255u) * c1[0]) * siluf_(v1[0]), (bfhi(y.z) + (float)((q.y >> 8) & 255u) * c1[1]) * siluf_(v1[1]));
                        w.w = pk2((bflo(y.w) + (float)((q.y >> 16) & 255u) * c1[2]) * siluf_(v1[2]), (bfhi(y.w) + (float)(q.y >> 24) * c1[3]) * siluf_(v1[3]));
                        if (!dry) *(u32x4*)(Y + ro + bj * 128) = w; }
                    asm volatile("" ::: "memory"); }
            } else {
                bf16_t* MG = (bf16_t*)(ws + WS_MG); const int col0 = (pn - 8) * 256 + cw;
#pragma unroll
                for (int ai = 0; ai < 2; ++ai)
#pragma unroll
                    for (int m = 0; m < 4; ++m) { bf16_t* rowp = MG + (size_t)(row0 + ai * 128 + m * 16) * 3072 + col0;
#pragma unroll
                        for (int bj = 0; bj < 2; ++bj) { const f32x4 v0 = acc[ai][bj][m][0], v1 = acc[ai][bj][m][1];
                            u32x4 w; w.x = pk2(sigmoidf_(v0[0]), sigmoidf_(v0[1])); w.y = pk2(sigmoidf_(v0[2]), sigmoidf_(v0[3])); w.z = pk2(sigmoidf_(v1[0]), sigmoidf_(v1[1])); w.w = pk2(sigmoidf_(v1[2]), sigmoidf_(v1[3]));
                            *(u32x4*)(rowp + bj * 128) = w; } }
            }
        }
    }
};

struct EpiG2 {
    static constexpr bool PERM = true, KHOOK = true;
    GAS unsigned char* ws;
    DI void scale(f32x4 (&acc)[2][2][4][2], const pg8::Unit& u, int wr, int wc, int, int, int brn, int brd) const {
        const int ln_ = lane_id(), fr = ln_ & 15, fq = ln_ >> 4;
        const bf16_t* MG = (const bf16_t*)(ws + WS_MG);
        const int row0 = u.pm * 256 + wr * 64 + fr, col0 = u.pn * 256 + wc * 32 + 8 * fq;
#pragma unroll
        for (int ai = 0; ai < 2; ++ai) {
            u32x4 nu[4][2], de[4][2];
#pragma unroll
            for (int m = 0; m < 4; ++m) { const bf16_t* rowp = MG + (size_t)(row0 + ai * 128 + m * 16) * 3072 + col0;
#pragma unroll
                for (int bj = 0; bj < 2; ++bj) { nu[m][bj] = *(const u32x4*)(rowp + brn * 1024 + bj * 128); if (brd >= 0) de[m][bj] = *(const u32x4*)(rowp + brd * 1024 + bj * 128); } }
#pragma unroll
            for (int m = 0; m < 4; ++m)
#pragma unroll
                for (int bj = 0; bj < 2; ++bj) {
                    const u32x4 n4 = nu[m][bj];
                    float r[8] = {bflo(n4.x), bfhi(n4.x), bflo(n4.y), bfhi(n4.y), bflo(n4.z), bfhi(n4.z), bflo(n4.w), bfhi(n4.w)};
                    if (brd >= 0) { const u32x4 d4 = de[m][bj];
                        const float d[8] = {bflo(d4.x), bfhi(d4.x), bflo(d4.y), bfhi(d4.y), bflo(d4.z), bfhi(d4.z), bflo(d4.w), bfhi(d4.w)};
#pragma unroll
                        for (int e = 0; e < 8; ++e) r[e] = r[e] * __builtin_amdgcn_rcpf(d[e]); }
#pragma unroll
                    for (int e = 0; e < 4; ++e) { acc[ai][bj][m][0][e] *= r[e]; acc[ai][bj][m][1][e] *= r[4 + e]; }
                }
            asm volatile("" ::: "memory");
        }
    }
    DI void khook(f32x4 (&acc)[2][2][4][2], const pg8::Unit& u, int t, int wr, int wc, int fr, int fq) const {
        if (t == 16 || t == 24) { const int brn = (t == 16) ? 0 : 1; scale(acc, u, wr, wc, fr, fq, brn, brn + 1); }
    }
    DI void operator()(f32x4 (&acc)[2][2][4][2], const pg8::Unit& u, int wr, int wc, int, int) const {
        scale(acc, u, wr, wc, 0, 0, 2, -1);
        const int ln_ = lane_id(), fr = ln_ & 15, fq = ln_ >> 4;
        bf16_t* O = (bf16_t*)(ws + WS_MERGED);
        const int row0 = u.pm * 256 + wr * 64 + fr, col0 = u.pn * 256 + wc * 32 + 8 * fq;
#pragma unroll
        for (int ai = 0; ai < 2; ++ai)
#pragma unroll
            for (int m = 0; m < 4; ++m) { bf16_t* rowp = O + (size_t)(row0 + ai * 128 + m * 16) * 1024 + col0;
#pragma unroll
                for (int bj = 0; bj < 2; ++bj) { const f32x4 v0 = acc[ai][bj][m][0], v1 = acc[ai][bj][m][1];
                    u32x4 w; w.x = pk2(v0[0], v0[1]); w.y = pk2(v0[2], v0[3]); w.z = pk2(v1[0], v1[1]); w.w = pk2(v1[2], v1[3]);
                    *(u32x4*)(rowp + bj * 128) = w; } }
    }
};

struct EpiNull {
    static constexpr bool PERM = true, KHOOK = false;
    DI void operator()(f32x4 (&acc)[2][2][4][2], const pg8::Unit&, int, int, int, int) const {
#pragma unroll
        for (int ai = 0; ai < 2; ++ai)
#pragma unroll
            for (int bj = 0; bj < 2; ++bj)
#pragma unroll
                for (int m = 0; m < 4; ++m)
#pragma unroll
                    for (int n = 0; n < 2; ++n) asm volatile("" :: "v"(acc[ai][bj][m][n]));
    }
};
struct EpiG3 {
    static constexpr bool PERM = false, KHOOK = false;
    const float* xin; float* out; const float* gate;
    DI void operator()(f32x4 (&acc)[2][2][4][2], const pg8::Unit& u, int wr, int wc, int, int) const {
        const int ln_ = lane_id(), fr = ln_ & 15, fq = ln_ >> 4;
        const int row0 = u.pm * 256 + wr * 64 + fr, col0 = u.pn * 256 + wc * 32 + 4 * fq, b = (u.pm * 256) >> 13;
        f32x4 gv[2][2];
#pragma unroll
        for (int bj = 0; bj < 2; ++bj)
#pragma unroll
            for (int n = 0; n < 2; ++n) gv[bj][n] = *(const f32x4*)(gate + b * 3072 + col0 + bj * 128 + n * 16);
#pragma unroll
        for (int ai = 0; ai < 2; ++ai)
#pragma unroll
            for (int m = 0; m < 4; ++m) { const size_t off = (size_t)(row0 + ai * 128 + m * 16) * 1024 + col0;
#pragma unroll
                for (int bj = 0; bj < 2; ++bj)
#pragma unroll
                    for (int n = 0; n < 2; ++n) { const f32x4 xv = *(const f32x4*)(xin + off + bj * 128 + n * 16);
                        *(f32x4*)(out + off + bj * 128 + n * 16) = xv + gv[bj][n] * acc[ai][bj][m][n]; } }
    }
};

DI u32x4 widen_pair(u32x2 ev, u32x2 od) {
    const auto rx = __builtin_amdgcn_permlane32_swap(ev.x, od.x, false, false);
    const auto ry = __builtin_amdgcn_permlane32_swap(ev.y, od.y, false, false);
    u32x4 w; w.x = rx[0]; w.y = ry[0]; w.z = rx[1]; w.w = ry[1]; return w;
}
typedef short v4i16_t __attribute__((ext_vector_type(4)));
DI s16x4 tr_read(const LAS void* p) { return __builtin_bit_cast(s16x4, __builtin_amdgcn_ds_read_tr16_b64_v4i16((LAS v4i16_t*)p)); }
constexpr int AT_PITCH = 144, AT_VP = 192, AT_K = 0, AT_V = 384 * AT_PITCH;
struct AttPre { u32x4 k[6], v[6]; bf16x8 qf[4]; };
DI void att_decode(int ub, int& g, int& b, int& hh, int& dsh, int& r, int& m0) {
    const int x8 = ub & 31; hh = (ub >> 5) & 7; b = (ub >> 8) & 1; g = ub >> 9;
    dsh = 2 * g; r = x8 >> (5 - dsh); const int cb = x8 & ((32 >> dsh) - 1); m0 = 256 * cb;
}
DI void att_issue(AttPre& p, int ub, const Frame& F, int lane) {
    const int tid = F.wave * 64 + lane;
    const bf16_t* Qb = (const bf16_t*)(F.ws + WS_Q); const bf16_t* Kb = (const bf16_t*)(F.ws + WS_K); const bf16_t* Vb = (const bf16_t*)(F.ws + WS_VT);
    int g, b, hh, dsh, r, m0; att_decode(ub, g, b, hh, dsh, r, m0);
    const int colb = g * 512 + hh * 64;
#pragma unroll
    for (int i = 0; i < 6; ++i) {
        const int c = tid + NTHR * i, j = c >> 3, ch = c & 7, ci = m0 - 128 + j;
        if (ci >= 0) { const size_t off = ((size_t)b * 8192 + ((size_t)ci << dsh) + r) * 1536 + colb + 8 * ch; p.k[i] = *(const u32x4*)(Kb + off); p.v[i] = *(const u32x4*)(Vb + off); }
    }
    const int ql = lane & 31, h = lane >> 5;
    const size_t tokq = (size_t)b * 8192 + ((size_t)(m0 + 32 * F.wave + ql) << dsh) + r;
    const bf16_t* qp = Qb + tokq * 1536 + colb + 8 * h;
#pragma unroll
    for (int kk = 0; kk < 4; ++kk) p.qf[kk] = *(const bf16x8*)(qp + 16 * kk);
}
DI void att_computeA(const AttPre& p, int ub, const Frame& F, int lane) {
    const int tid = F.wave * 64 + lane;
    int g, b, hh, dsh, r, m0; att_decode(ub, g, b, hh, dsh, r, m0);
    LAS unsigned char* Kl = F.lds + AT_K; LAS unsigned char* Vl = F.lds + AT_V;
#pragma unroll
    for (int i = 0; i < 6; ++i) {
        const int c = tid + NTHR * i, j = c >> 3, ch = c & 7, ci = m0 - 128 + j;
        if (ci >= 0) { *(LAS u32x4*)(Kl + j * AT_PITCH + ch * 16) = p.k[i]; *(LAS u32x4*)(Vl + j * AT_VP + ch * 16) = p.v[i]; }
    }
    __syncthreads();
}
DI void att_computeB(const bf16x8 (&qf)[4], int ub, const Frame& F, int lane, bool dry) {
    bf16_t* Qb = (bf16_t*)(F.ws + WS_Q); float* LSE = (float*)(F.ws + WS_LSE);
    int g, b, hh, dsh, r, m0; att_decode(ub, g, b, hh, dsh, r, m0);
    const int colb = g * 512 + hh * 64;
    LAS unsigned char* Kl = F.lds + AT_K; LAS unsigned char* Vl = F.lds + AT_V;
    const int w = F.wave, ql = lane & 31, h = lane >> 5;
    const int mq = m0 + 32 * w + ql;
    const size_t tokq = (size_t)b * 8192 + ((size_t)mq << dsh) + r;
    f32x16 st[5];
    float l = 0.f;
    f32x16 zero16;
#pragma unroll
    for (int i = 0; i < 16; ++i) zero16[i] = 0.f;
#pragma unroll
    for (int kt = 0; kt < 5; ++kt) {
        const int jr = 32 * w + 32 * kt;
        if (m0 - 128 + jr >= 0) {
            const LAS unsigned char* kp = Kl + (jr + ql) * AT_PITCH + 16 * h;
            f32x16 acc = MFMA32(*(const LAS bf16x8*)(kp), qf[0], zero16);
#pragma unroll
            for (int kk = 1; kk < 4; ++kk) { const bf16x8 kf = *(const LAS bf16x8*)(kp + 32 * kk); acc = MFMA32(kf, qf[kk], acc); }
#pragma unroll
            for (int i = 0; i < 16; ++i) {
                float p = __builtin_amdgcn_exp2f(acc[i]);
                if (kt == 0) { if (crow(i, h) < ql) p = 0.f; }
                if (kt == 4) { if (crow(i, h) > ql) p = 0.f; }
                acc[i] = p; l += p; }
            st[kt] = acc;
        } else st[kt] = zero16;
    }
    l += shx(l, lane, 32);
    f32x16 o[2];
#pragma unroll
    for (int i = 0; i < 16; ++i) { o[0][i] = 0.f; o[1][i] = 0.f; }
    const int G = lane >> 4, i16 = lane & 15;
    const LAS unsigned char* vl = Vl + (4 * (G >> 1) + (i16 >> 2)) * AT_VP + (16 * (G & 1) + 4 * (i16 & 3)) * 2;
#pragma unroll
    for (int kt = 0; kt < 5; ++kt) {
        const int jr = 32 * w + 32 * kt;
        if (m0 - 128 + jr >= 0) {
#pragma unroll
            for (int s = 0; s < 2; ++s) {
                const bf16x8 pb = pack_step(st[kt], s);
#pragma unroll
                for (int db = 0; db < 2; ++db) {
                    const LAS unsigned char* vp = vl + (jr + 16 * s) * AT_VP + 64 * db;
                    const s16x4 lo = tr_read(vp), hi = tr_read(vp + 8 * AT_VP);
                    const bf16x8 va = __builtin_shufflevector(lo, hi, 0, 1, 2, 3, 4, 5, 6, 7);
                    o[db] = MFMA32(va, pb, o[db]);
                }
            }
        }
    }
    const float inv = 1.0f / l;
    bf16_t* op = Qb + tokq * 1536 + colb + 8 * h;
#pragma unroll
    for (int db = 0; db < 2; ++db)
#pragma unroll
        for (int pq = 0; pq < 2; ++pq) {
            u32x2 ev, od;
            ev.x = pk2(o[db][8 * pq] * inv, o[db][8 * pq + 1] * inv); ev.y = pk2(o[db][8 * pq + 2] * inv, o[db][8 * pq + 3] * inv);
            od.x = pk2(o[db][8 * pq + 4] * inv, o[db][8 * pq + 5] * inv); od.y = pk2(o[db][8 * pq + 6] * inv, o[db][8 * pq + 7] * inv);
            const u32x4 wv = widen_pair(ev, od);
            if (!dry) *(u32x4*)(op + 32 * db + 16 * pq) = wv;
        }
    if (h == 0 && !dry) LSE[(tokq * 3 + g) * 8 + hh] = __builtin_amdgcn_logf(l);
    __syncthreads();
}
DI void att_units(const Frame& F, bool dry = false) {
    if (F.vcu >= 1536) return;
    AttPre cur;
    att_issue(cur, F.vcu, F, lane_id());
    for (int ub = F.vcu; ub < 1536; ub += F.G) {
        const int lane = lane_id();
        att_computeA(cur, ub, F, lane);
        bf16x8 qf[4];
#pragma unroll
        for (int kk = 0; kk < 4; ++kk) qf[kk] = cur.qf[kk];
        if (ub + F.G < 1536) att_issue(cur, ub + F.G, F, lane);
        att_computeB(qf, ub, F, lane, dry);
    }
}

DI void yb_unit(int u, const Frame& F) {
    FRAME_LT;
    const bf16_t* O = (const bf16_t*)(F.ws + WS_Q); const float* LSE = (const float*)(F.ws + WS_LSE); bf16_t* YB = (bf16_t*)(F.ws + WS_YB);
#pragma unroll
    for (int i = 0; i < 8; ++i) {
        const int it = tid + NTHR * i; const size_t tok = (size_t)u * 64 + (it >> 6); const int c8 = it & 63, hs = c8 >> 3, d0 = (c8 & 7) * 8;
        const float l0 = LSE[(tok * 3 + 0) * 8 + hs], l1 = LSE[(tok * 3 + 1) * 8 + hs], l2 = LSE[(tok * 3 + 2) * 8 + hs];
        const float mx = fmaxf(l0, fmaxf(l1, l2));
        float w0 = __builtin_amdgcn_exp2f(l0 - mx), w1 = __builtin_amdgcn_exp2f(l1 - mx), w2 = __builtin_amdgcn_exp2f(l2 - mx);
        const float inv = 1.0f / (w0 + w1 + w2); w0 *= inv; w1 *= inv; w2 *= inv;
        const bf16_t* op = O + tok * 1536 + hs * 64 + d0;
        const u32x4 a = *(const u32x4*)(op), bq = *(const u32x4*)(op + 512), c = *(const u32x4*)(op + 1024);
        const u32x4 gt = *(const u32x4*)((const bf16_t*)(F.ws + WS_BG) + tok * 512 + hs * 64 + d0);
        u32x4 w;
        w.x = pk2((w0 * bflo(a.x) + w1 * bflo(bq.x) + w2 * bflo(c.x)) * bflo(gt.x), (w0 * bfhi(a.x) + w1 * bfhi(bq.x) + w2 * bfhi(c.x)) * bfhi(gt.x));
        w.y = pk2((w0 * bflo(a.y) + w1 * bflo(bq.y) + w2 * bflo(c.y)) * bflo(gt.y), (w0 * bfhi(a.y) + w1 * bfhi(bq.y) + w2 * bfhi(c.y)) * bfhi(gt.y));
        w.z = pk2((w0 * bflo(a.z) + w1 * bflo(bq.z) + w2 * bflo(c.z)) * bflo(gt.z), (w0 * bfhi(a.z) + w1 * bfhi(bq.z) + w2 * bfhi(c.z)) * bfhi(gt.z));
        w.w = pk2((w0 * bflo(a.w) + w1 * bflo(bq.w) + w2 * bflo(c.w)) * bflo(gt.w), (w0 * bfhi(a.w) + w1 * bfhi(bq.w) + w2 * bfhi(c.w)) * bfhi(gt.w));
        *(u32x4*)(YB + tok * 1024 + hs * 64 + d0) = w;
    }
}

struct GlaPre1 { u32x4 rk[2], v[4]; f32x4 lr; };
struct GlaPre3 { u32x4 rq[2], rk[2], v[4]; f32x4 lr; };
constexpr int G_W = 116736, G_WB = G_W + 8192, G_ONG = G_WB + 512;
DI void gla_stage_w(const Frame& F, int hd, const Args& a, int l, int tid) {
    const float* a2 = ARGIN(a, 17) + (size_t)l * 16 * 512; const float* ab = ARGIN(a, 18) + (size_t)l * 512; const float* ong = ARGIN(a, 19) + (size_t)l * 256;
    LAS float* W = (LAS float*)(F.lds + G_W); LAS float* WB = (LAS float*)(F.lds + G_WB); LAS float* ONG = (LAS float*)(F.lds + G_ONG);
    for (int i = tid; i < 2048; i += NTHR) W[i] = a2[(i >> 7) * 512 + hd * 128 + (i & 127)];
    if (tid < 128) WB[tid] = ab[hd * 128 + tid];
    if (tid < 256) ONG[tid] = ong[tid];
    __syncthreads();
}
template <class PRE, bool P3> DI void gla_issue(PRE& p, int bh, int n, const Frame& F, int lane) {
    const int tid = F.wave * 64 + lane;
    const int b = bh >> 2, hd = bh & 3;
    const bf16_t* CK = (const bf16_t*)(F.ws + WS_CK); const bf16_t* CV = (const bf16_t*)(F.ws + WS_CV);
    const size_t tok0 = (size_t)b * 8192 + n * 64;
#pragma unroll
    for (int i = 0; i < 2; ++i) { const int c = tid + NTHR * i, s = c >> 4, kd0 = (c & 15) * 8; p.rk[i] = *(const u32x4*)(CK + (tok0 + s) * 512 + hd * 128 + kd0); }
#pragma unroll
    for (int i = 0; i < 4; ++i) { const int c = tid + NTHR * i, s = c >> 5, vd0 = (c & 31) * 8; p.v[i] = *(const u32x4*)(CV + (tok0 + s) * 1024 + hd * 256 + vd0); }
    p.lr = *(const f32x4*)((const float*)(F.ws + WS_LR) + tok0 * 16 + 4 * (tid & 255));
    if constexpr (P3) {
        const bf16_t* CQ = (const bf16_t*)(F.ws + WS_CQ);
#pragma unroll
        for (int i = 0; i < 2; ++i) { const int c = tid + NTHR * i, s = c >> 4, kd0 = (c & 15) * 8; p.rq[i] = *(const u32x4*)(CQ + (tok0 + s) * 512 + hd * 128 + kd0); }
    }
}
DI void gla_cumsum(LAS float* Bc, LAS float* tot, LAS float* lrt, const f32x4 lrv, const LAS float* W, const LAS float* WB, int tid) {
    const int kd = tid & 127, part = tid >> 7;
    if (tid < 256) *(LAS f32x4*)(lrt + 4 * tid) = lrv;
    struct { float w[16]; float bias; } p;
#pragma unroll
    for (int r = 0; r < 16; ++r) p.w[r] = W[r * 128 + kd];
    p.bias = WB[kd];
    __syncthreads();
    float run = 0.f;
#pragma unroll 4
    for (int s = 0; s < 16; ++s) {
        const LAS f32x4* lr = (const LAS f32x4*)(lrt + (part * 16 + s) * 16);
        float pre = p.bias;
#pragma unroll
        for (int q = 0; q < 4; ++q) { const f32x4 v = lr[q]; pre += v[0] * p.w[4 * q] + v[1] * p.w[4 * q + 1] + v[2] * p.w[4 * q + 2] + v[3] * p.w[4 * q + 3]; }
        const float la = (fminf(pre, 0.f) - __logf(1.0f + __expf(-fabsf(pre)))) * (1.0f / 16.0f);
        run += la; Bc[(part * 16 + s) * 128 + kd] = run;
    }
    tot[part * 128 + kd] = run;
    __syncthreads();
    float off = 0.f;
#pragma unroll
    for (int q = 0; q < 3; ++q) if (q < part) off += tot[q * 128 + kd];
    if (part > 0) {
#pragma unroll 4
        for (int s = 0; s < 16; ++s) Bc[(part * 16 + s) * 128 + kd] += off;
    }
    __syncthreads();
}
constexpr int G_BC = 0, G_TOT = 32768, G_LRT = 34816, G_A = 38912;
constexpr int KP = 272, KPT = 320, VP = 576;
constexpr int G1_KE = G_A, G1_VL = G1_KE + 64 * KPT;
constexpr int G3_QD = G_A, G3_KI = G3_QD + 64 * KP, G3_VL = G3_KI + 64 * KP, G3_SSQ = G3_VL + 64 * VP;
template <class PRE> DI void gla_store_v(LAS unsigned char* VL, const PRE& p, int tid) {
#pragma unroll
    for (int i = 0; i < 4; ++i) { const int c = tid + NTHR * i, s = c >> 5, vd0 = (c & 31) * 8; *(LAS u32x4*)(VL + s * VP + vd0 * 2) = p.v[i]; }
}
DI int tr_lane_off(int lane, int P, int hsel) { const int G = lane >> 4, i16 = lane & 15; return (hsel * (G >> 1) + (i16 >> 2)) * P + (16 * (G & 1) + 4 * (i16 & 3)) * 2; }
DI void gla1_computeA(const GlaPre1& p, float& Dp, const Frame& F, int lane) {
    const int tid = F.wave * 64 + lane;
    LAS float* Bc = (LAS float*)(F.lds + G_BC); LAS float* tot = (LAS float*)(F.lds + G_TOT); LAS float* lrt = (LAS float*)(F.lds + G_LRT);
    LAS unsigned char* KE = F.lds + G1_KE; LAS unsigned char* VL = F.lds + G1_VL;
    gla_store_v(VL, p, tid);
    gla_cumsum(Bc, tot, lrt, p.lr, (const LAS float*)(F.lds + G_W), (const LAS float*)(F.lds + G_WB), tid);
    if (tid < 128) { const float d = __expf(Bc[63 * 128 + tid]); tot[tid] = d; Dp *= d; }
#pragma unroll
    for (int i = 0; i < 2; ++i) { const int c = tid + NTHR * i, s = c >> 4, kd0 = (c & 15) * 8;
        const unsigned wv[4] = {p.rk[i].x, p.rk[i].y, p.rk[i].z, p.rk[i].w};
        u32x4 o;
#pragma unroll
        for (int e = 0; e < 4; ++e) { const float f0 = __expf(Bc[63 * 128 + kd0 + 2 * e] - Bc[s * 128 + kd0 + 2 * e]), f1 = __expf(Bc[63 * 128 + kd0 + 2 * e + 1] - Bc[s * 128 + kd0 + 2 * e + 1]);
            o[e] = pk2(bflo(wv[e]) * f0, bfhi(wv[e]) * f1); }
        *(LAS u32x4*)(KE + s * KPT + kd0 * 2) = o; }
    __syncthreads();
}
DI void gla1_computeB(f32x16 (&S)[4], bool first, const Frame& F, int lane) {
    LAS unsigned char* KE = F.lds + G1_KE; LAS unsigned char* VL = F.lds + G1_VL; const LAS float* Bc = (const LAS float*)(F.lds + G_TOT);
    const int h = lane >> 5, w = F.wave;
    const LAS unsigned char* vbase = VL + tr_lane_off(lane, VP, 8) + 32 * w * 2;
    const LAS unsigned char* kbase = KE + tr_lane_off(lane, KPT, 8);
    bf16x8 vb[4];
#pragma unroll
    for (int kk = 0; kk < 4; ++kk) { const s16x4 lo = tr_read(vbase + 16 * kk * VP), hi = tr_read(vbase + (16 * kk + 4) * VP); vb[kk] = __builtin_shufflevector(lo, hi, 0, 1, 2, 3, 4, 5, 6, 7); }
#pragma unroll
    for (int mt = 0; mt < 4; ++mt) {
        if (first) {
#pragma unroll
            for (int i = 0; i < 16; ++i) S[mt][i] = 0.f;
        } else {
#pragma unroll
            for (int gq = 0; gq < 4; ++gq) { const f32x4 dl = *(const LAS f32x4*)(Bc + 32 * mt + 8 * gq + 4 * h);
#pragma unroll
                for (int e = 0; e < 4; ++e) S[mt][4 * gq + e] *= dl[e]; }
        }
#pragma unroll
        for (int kk = 0; kk < 4; ++kk) { const s16x4 lo = tr_read(kbase + 16 * kk * KPT + 64 * mt), hi = tr_read(kbase + (16 * kk + 4) * KPT + 64 * mt);
            const bf16x8 ka = __builtin_shufflevector(lo, hi, 0, 1, 2, 3, 4, 5, 6, 7); S[mt] = MFMA32(ka, vb[kk], S[mt]); }
    }
    __syncthreads();
}
DI void gla2_unit(int u, const Frame& F, bool dry = false) {
    FRAME_LT;
    const int gid = u * NTHR + tid, bh = gid >> 14, fi = (gid & 16383) * 2;
    const int within = fi & 4095, mtgq = within >> 8, ln = (within >> 2) & 63, e = within & 3;
    const int kd = 32 * (mtgq >> 2) + 8 * (mtgq & 3) + 4 * (ln >> 5) + e;
    f32x2* p = (f32x2*)((float*)(F.ws + WS_KV) + (size_t)bh * 32 * 32768 + fi);
    const f32x2* dp = (const f32x2*)((const float*)(F.ws + WS_GDEC) + (size_t)bh * 32 * 128 + kd);
    f32x2 cur[32], dc[32];
#pragma unroll
    for (int g = 0; g < 32; ++g) { cur[g] = p[(size_t)g * 16384]; dc[g] = dp[(size_t)g * 64]; }
    float s0 = 0.f, s1 = 0.f; asm volatile("" : "+v"(s0), "+v"(s1));
#pragma unroll
    for (int g = 0; g < 32; ++g) { if (!dry) p[(size_t)g * 16384] = (f32x2){s0, s1}; s0 = dc[g].x * s0 + cur[g].x; s1 = dc[g].y * s1 + cur[g].y; }
}
DI void gla3_computeA(const GlaPre3& p, const Frame& F, int lane) {
    const int tid = F.wave * 64 + lane;
    LAS float* Bc = (LAS float*)(F.lds + G_BC); LAS float* tot = (LAS float*)(F.lds + G_TOT); LAS float* lrt = (LAS float*)(F.lds + G_LRT);
    LAS unsigned char* QD = F.lds + G3_QD; LAS unsigned char* KI = F.lds + G3_KI; LAS unsigned char* VL = F.lds + G3_VL;
    gla_store_v(VL, p, tid);
    gla_cumsum(Bc, tot, lrt, p.lr, (const LAS float*)(F.lds + G_W), (const LAS float*)(F.lds + G_WB), tid);
#pragma unroll
    for (int i = 0; i < 2; ++i) { const int c = tid + NTHR * i, s = c >> 4, kd0 = (c & 15) * 8;
        const unsigned wq[4] = {p.rq[i].x, p.rq[i].y, p.rq[i].z, p.rq[i].w}, wk[4] = {p.rk[i].x, p.rk[i].y, p.rk[i].z, p.rk[i].w};
        u32x4 oq, ok;
#pragma unroll
        for (int e = 0; e < 4; ++e) { const float b0 = Bc[s * 128 + kd0 + 2 * e], b1 = Bc[s * 128 + kd0 + 2 * e + 1];
            oq[e] = pk2(bflo(wq[e]) * __expf(b0), bfhi(wq[e]) * __expf(b1)); ok[e] = pk2(bflo(wk[e]) * __expf(-b0), bfhi(wk[e]) * __expf(-b1)); }
        *(LAS u32x4*)(QD + s * KP + kd0 * 2) = oq; *(LAS u32x4*)(KI + s * KP + kd0 * 2) = ok; }
    if (tid < 128) tot[tid] = __expf(Bc[63 * 128 + tid]);
    __syncthreads();
}
DI void gla3_computeB(f32x16 (&P)[4], bool last, int bh, int n, const Frame& F, int lane, bool dry) {
    const int b = bh >> 2, hd = bh & 3;
    LAS unsigned char* QD = F.lds + G3_QD; LAS unsigned char* KI = F.lds + G3_KI; LAS unsigned char* VL = F.lds + G3_VL;
    LAS float* SSQ = (LAS float*)(F.lds + G3_SSQ);
    bf16_t* CV = (bf16_t*)(F.ws + WS_CV);
    const size_t tok0 = (size_t)b * 8192 + n * 64;
    const int ql = lane & 31, h = lane >> 5, w = F.wave;
    f32x16 at00, at01, at11;
#pragma unroll
    for (int i = 0; i < 16; ++i) { at00[i] = 0.f; at01[i] = 0.f; at11[i] = 0.f; }
    const LAS unsigned char* kr = KI + ql * KP + 16 * h; const LAS unsigned char* qr = QD + ql * KP + 16 * h;
#pragma unroll
    for (int kk = 0; kk < 8; ++kk) {
        const bf16x8 k0 = *(const LAS bf16x8*)(kr + 32 * kk), k1 = *(const LAS bf16x8*)(kr + 32 * KP + 32 * kk);
        const bf16x8 q0 = *(const LAS bf16x8*)(qr + 32 * kk), q1 = *(const LAS bf16x8*)(qr + 32 * KP + 32 * kk);
        at00 = MFMA32(k0, q0, at00); at01 = MFMA32(k0, q1, at01); at11 = MFMA32(k1, q1, at11);
    }
#pragma unroll
    for (int i = 0; i < 16; ++i) { const int s = crow(i, h); if (s > ql) { at00[i] = 0.f; at11[i] = 0.f; } }
    f32x16 o[2];
#pragma unroll
    for (int i = 0; i < 16; ++i) { o[0][i] = 0.f; o[1][i] = 0.f; }
    const LAS unsigned char* vbase = VL + tr_lane_off(lane, VP, 4) + 32 * w * 2;
#pragma unroll
    for (int s = 0; s < 2; ++s) {
        { const s16x4 lo = tr_read(vbase + (16 * s) * VP), hi = tr_read(vbase + (16 * s + 8) * VP);
          const bf16x8 va = __builtin_shufflevector(lo, hi, 0, 1, 2, 3, 4, 5, 6, 7);
          o[0] = MFMA32(va, pack_step(at00, s), o[0]); o[1] = MFMA32(va, pack_step(at01, s), o[1]); }
        { const s16x4 lo = tr_read(vbase + (32 + 16 * s) * VP), hi = tr_read(vbase + (32 + 16 * s + 8) * VP);
          const bf16x8 va = __builtin_shufflevector(lo, hi, 0, 1, 2, 3, 4, 5, 6, 7);
          o[1] = MFMA32(va, pack_step(at11, s), o[1]); }
    }
#pragma unroll
    for (int mt = 0; mt < 4; ++mt)
#pragma unroll
        for (int s = 0; s < 2; ++s) {
            const bf16x8 pa = pack_step(P[mt], s);
            const LAS unsigned char* q0p = QD + ql * KP + (32 * mt + 16 * s + 4 * h) * 2;
            const s16x4 a0 = *(const LAS s16x4*)(q0p), a1 = *(const LAS s16x4*)(q0p + 16), b0 = *(const LAS s16x4*)(q0p + 32 * KP), b1 = *(const LAS s16x4*)(q0p + 32 * KP + 16);
            o[0] = MFMA32(pa, __builtin_shufflevector(a0, a1, 0, 1, 2, 3, 4, 5, 6, 7), o[0]);
            o[1] = MFMA32(pa, __builtin_shufflevector(b0, b1, 0, 1, 2, 3, 4, 5, 6, 7), o[1]);
        }
    if (!last) {
        const LAS float* DEC = (const LAS float*)(F.lds + G_TOT);
        const LAS unsigned char* vnb = VL + tr_lane_off(lane, VP, 8) + 32 * w * 2;
        const LAS unsigned char* kib = KI + tr_lane_off(lane, KP, 8);
        bf16x8 vbn[4];
#pragma unroll
        for (int kk = 0; kk < 4; ++kk) { const s16x4 lo = tr_read(vnb + 16 * kk * VP), hi = tr_read(vnb + (16 * kk + 4) * VP); vbn[kk] = __builtin_shufflevector(lo, hi, 0, 1, 2, 3, 4, 5, 6, 7); }
#pragma unroll
        for (int mt = 0; mt < 4; ++mt) {
#pragma unroll
            for (int kk = 0; kk < 4; ++kk) { const s16x4 lo = tr_read(kib + 16 * kk * KP + 64 * mt), hi = tr_read(kib + (16 * kk + 4) * KP + 64 * mt);
                P[mt] = MFMA32(__builtin_shufflevector(lo, hi, 0, 1, 2, 3, 4, 5, 6, 7), vbn[kk], P[mt]); }
#pragma unroll
            for (int gq = 0; gq < 4; ++gq) { const f32x4 dl = *(const LAS f32x4*)(DEC + 32 * mt + 8 * gq + 4 * h);
#pragma unroll
                for (int e = 0; e < 4; ++e) P[mt][4 * gq + e] *= dl[e]; }
        }
    }
#pragma unroll
    for (int qt = 0; qt < 2; ++qt) { float ss = 0.f;
#pragma unroll
        for (int i = 0; i < 16; ++i) ss += o[qt][i] * o[qt][i];
        ss += shx(ss, lane, 32);
        if (h == 0) SSQ[w * 64 + 32 * qt + ql] = ss; }
    __syncthreads();
#pragma unroll
    for (int qt = 0; qt < 2; ++qt) {
        float ss = 0.f;
#pragma unroll
        for (int ww = 0; ww < 8; ++ww) ss += SSQ[ww * 64 + 32 * qt + ql];
        const float rinv = 1.0f / sqrtf(ss * (1.f / 256.f) + EPS);
        bf16_t* dst = CV + (tok0 + 32 * qt + ql) * 1024 + hd * 256 + 32 * w + 8 * h;
#pragma unroll
        for (int pq = 0; pq < 2; ++pq) {
            const f32x4 ge = *(const LAS f32x4*)(F.lds + G_ONG + (32 * w + 16 * pq + 4 * h) * 4), go = *(const LAS f32x4*)(F.lds + G_ONG + (32 * w + 16 * pq + 8 + 4 * h) * 4);
            u32x2 ev, od;
            ev.x = pk2(o[qt][8 * pq] * rinv * ge[0], o[qt][8 * pq + 1] * rinv * ge[1]); ev.y = pk2(o[qt][8 * pq + 2] * rinv * ge[2], o[qt][8 * pq + 3] * rinv * ge[3]);
            od.x = pk2(o[qt][8 * pq + 4] * rinv * go[0], o[qt][8 * pq + 5] * rinv * go[1]); od.y = pk2(o[qt][8 * pq + 6] * rinv * go[2], o[qt][8 * pq + 7] * rinv * go[3]);
            const u32x4 wv = widen_pair(ev, od);
            if (!dry) *(u32x4*)(dst + 16 * pq) = wv; }
    }
    __syncthreads();
}
DI void gla1_units(const Frame& F, const Args& a, int l) {
    for (int su = F.vcu; su < 256; su += F.G) {
        const int bh = su & 7, g = su >> 3;
        { const int lane = lane_id(); gla_stage_w(F, bh & 3, a, l, F.wave * 64 + lane); }
        GlaPre1 cur;
        gla_issue<GlaPre1, false>(cur, bh, 4 * g, F, lane_id());
        f32x16 S[4]; float Dp = 1.f;
        for (int i = 0; i < 4; ++i) {
            const int lane = lane_id();
            gla1_computeA(cur, Dp, F, lane);
            if (i < 3) gla_issue<GlaPre1, false>(cur, bh, 4 * g + i + 1, F, lane);
            gla1_computeB(S, i == 0, F, lane);
        }
        const int lane = lane_id();
        float* GS = (float*)(F.ws + WS_KV) + ((size_t)(bh * 32 + g) * 8 + F.wave) * 4096 + lane * 4;
#pragma unroll
        for (int mt = 0; mt < 4; ++mt)
#pragma unroll
            for (int gq = 0; gq < 4; ++gq) *(f32x4*)(GS + (mt * 4 + gq) * 256) = (f32x4){S[mt][4 * gq], S[mt][4 * gq + 1], S[mt][4 * gq + 2], S[mt][4 * gq + 3]};
        if (F.wave * 64 + lane < 128) ((float*)(F.ws + WS_GDEC))[(size_t)(bh * 32 + g) * 128 + F.wave * 64 + lane] = Dp;
    }
}
DI void gla3_units(const Frame& F, const Args& a, int l, bool dry = false) {
    for (int su = F.vcu; su < 256; su += F.G) {
        const int bh = su & 7, g = su >> 3;
        { const int lane = lane_id(); gla_stage_w(F, bh & 3, a, l, F.wave * 64 + lane); }
        GlaPre3 cur;
        f32x16 P[4];
        { const int lane = lane_id();
          gla_issue<GlaPre3, true>(cur, bh, 4 * g, F, lane);
          const float* GS = (const float*)(F.ws + WS_KV) + ((size_t)(bh * 32 + g) * 8 + F.wave) * 4096 + lane * 4;
#pragma unroll
          for (int mt = 0; mt < 4; ++mt)
#pragma unroll
              for (int gq = 0; gq < 4; ++gq) { const f32x4 v = *(const f32x4*)(GS + (mt * 4 + gq) * 256);
#pragma unroll
                  for (int e = 0; e < 4; ++e) P[mt][4 * gq + e] = v[e]; } }
        for (int i = 0; i < 4; ++i) {
            const int lane = lane_id();
            gla3_computeA(cur, F, lane);
            if (i < 3) gla_issue<GlaPre3, true>(cur, bh, 4 * g + i + 1, F, lane);
            gla3_computeB(P, i == 3, bh, 4 * g + i, F, lane, dry);
        }
    }
}

DI float fsigmoid(float x) { return __builtin_amdgcn_rcpf(1.0f + __builtin_amdgcn_exp2f(-LOG2E * x)); }
constexpr int LX_PITCH = 528;
constexpr int L_CW = 34816, L_CB = L_CW + 16384;
struct LruPre { u32x4 raw[7]; bf16x8 wa[4], wx[4]; float ba, bx, lam; };
template <bool FINAL> DI void lru_issue(LruPre& p, int u, const Frame& F, const Args& a, int l, int lane) {
    const int tid = F.wave * 64 + lane;
    const int cg = u & 3, c = (u >> 2) & 127, b = u >> 9, ch0 = cg * 256;
    const bf16_t* AX = (const bf16_t*)(F.ws + WS_AX);
    const int cc = (tid & 31) * 8, t0 = c * 64 + 4 * (tid >> 5) - 3;
#pragma unroll
    for (int j = 0; j < 7; ++j) { const int tt = t0 + j;
        if (tt >= 0) p.raw[j] = *(const u32x4*)(AX + ((size_t)b * 8192 + tt) * 1024 + ch0 + cc); else p.raw[j] = (u32x4){0u, 0u, 0u, 0u}; }
    const int w = F.wave, bl = w >> 1, nt = w & 1, ql = lane & 31, h = lane >> 5;
    const bf16_t* LW = (const bf16_t*)(F.ws + WS_LRUW) + (size_t)((cg * 4 + bl) * 2) * 4096 + (32 * nt + ql) * 64 + 8 * h;
#pragma unroll
    for (int kk = 0; kk < 4; ++kk) { p.wa[kk] = *(const bf16x8*)(LW + 16 * kk); p.wx[kk] = *(const bf16x8*)(LW + 4096 + 16 * kk); }
    const int chg = ch0 + bl * 64 + 32 * nt + ql;
    p.ba = -LOG2E * ARGIN(a, 10)[(size_t)l * 1024 + chg]; p.bx = -LOG2E * ARGIN(a, 12)[(size_t)l * 1024 + chg]; p.lam = ARGIN(a, 13)[(size_t)l * 1024 + chg];
}
DI void lru_stage_conv(const Frame& F, const Args& a, int l, int tid) {
    const float* cw = ARGIN(a, 7) + (size_t)l * 4 * 1024; const float* cb = ARGIN(a, 8) + (size_t)l * 1024;
    LAS float* CW = (LAS float*)(F.lds + L_CW); LAS float* CB = (LAS float*)(F.lds + L_CB);
    for (int i = tid; i < 1024; i += NTHR) { *(LAS f32x4*)(CW + 4 * i) = *(const f32x4*)(cw + 4 * i); }
    if (tid < 256) *(LAS f32x4*)(CB + 4 * tid) = *(const f32x4*)(cb + 4 * tid);
    __syncthreads();
}
template <bool FINAL> DI void lru_compute(const LruPre& p, int u, const Frame& F, int lane, bool dry) {
    const int tid = F.wave * 64 + lane;
    const int cg = u & 3, c = (u >> 2) & 127, b = u >> 9, ch0 = cg * 256;
    LAS unsigned char* XC = F.lds;
    {
        const LAS float* CW = (const LAS float*)(F.lds + L_CW); const LAS float* CB = (const LAS float*)(F.lds + L_CB);
        const int cc = (tid & 31) * 8, s0 = 4 * (tid >> 5);
        f32x4 wv[4][2], bv[2];
#pragma unroll
        for (int k = 0; k < 4; ++k) { wv[k][0] = *(const LAS f32x4*)(CW + k * 1024 + ch0 + cc); wv[k][1] = *(const LAS f32x4*)(CW + k * 1024 + ch0 + cc + 4); }
        bv[0] = *(const LAS f32x4*)(CB + ch0 + cc); bv[1] = *(const LAS f32x4*)(CB + ch0 + cc + 4);
#pragma unroll
        for (int e = 0; e < 4; ++e) {
            float acc[8];
#pragma unroll
            for (int q = 0; q < 4; ++q) { acc[q] = bv[0][q]; acc[4 + q] = bv[1][q]; }
#pragma unroll
            for (int k = 0; k < 4; ++k) { const u32x4 raw = p.raw[e + k];
                acc[0] += wv[k][0][0] * bflo(raw.x); acc[1] += wv[k][0][1] * bfhi(raw.x); acc[2] += wv[k][0][2] * bflo(raw.y); acc[3] += wv[k][0][3] * bfhi(raw.y);
                acc[4] += wv[k][1][0] * bflo(raw.z); acc[5] += wv[k][1][1] * bfhi(raw.z); acc[6] += wv[k][1][2] * bflo(raw.w); acc[7] += wv[k][1][3] * bfhi(raw.w); }
            u32x4 o; o.x = pk2(acc[0], acc[1]); o.y = pk2(acc[2], acc[3]); o.z = pk2(acc[4], acc[5]); o.w = pk2(acc[6], acc[7]);
            *(LAS u32x4*)(XC + (s0 + e) * LX_PITCH + cc * 2) = o; }
    }
    __syncthreads();
    {
        const int w = F.wave, bl = w >> 1, nt = w & 1, ql = lane & 31, h = lane >> 5;
        f32x16 ga[2], gx[2];
#pragma unroll
        for (int i = 0; i < 16; ++i) { ga[0][i] = p.ba; ga[1][i] = p.ba; gx[0][i] = p.bx; gx[1][i] = p.bx; }
#pragma unroll
        for (int kk = 0; kk < 4; ++kk) {
#pragma unroll
            for (int mt = 0; mt < 2; ++mt) { const bf16x8 xa = *(const LAS bf16x8*)(XC + (32 * mt + ql) * LX_PITCH + (bl * 64 + 16 * kk + 8 * h) * 2);
                ga[mt] = MFMA32(xa, p.wa[kk], ga[mt]); gx[mt] = MFMA32(xa, p.wx[kk], gx[mt]); }
        }
        const int chl = bl * 64 + 32 * nt + ql, chg = ch0 + chl;
        const float sp8 = -8.0f * LOG2E * log1pf(__expf(-p.lam));
#pragma unroll
        for (int mt = 0; mt < 2; ++mt)
#pragma unroll
            for (int i = 0; i < 16; ++i) { const int tok = 32 * mt + crow(i, h);
                const float r = __builtin_amdgcn_rcpf(1.0f + __builtin_amdgcn_exp2f(ga[mt][i])), ig = __builtin_amdgcn_rcpf(1.0f + __builtin_amdgcn_exp2f(gx[mt][i])), av = __builtin_amdgcn_exp2f(r * sp8);
                const float xc = bf2f(*(const LAS bf16_t*)(XC + tok * LX_PITCH + chl * 2));
                ga[mt][i] = av; gx[mt][i] = __builtin_amdgcn_sqrtf(1.0f - av * av) * (ig * xc); }
        float gA[8], gH[8], pA[8], pH[8], cin[8], ain[8];
#pragma unroll
        for (int k = 0; k < 8; ++k) { float A = 1.f, H = 0.f;
#pragma unroll
            for (int e = 0; e < 4; ++e) { const float av = ga[k >> 2][4 * (k & 3) + e], uv = gx[k >> 2][4 * (k & 3) + e]; H = av * H + uv; A *= av; }
            gA[k] = A; gH[k] = H; }
#pragma unroll
        for (int k = 0; k < 8; ++k) { pA[k] = shx(gA[k], lane, 32); pH[k] = shx(gH[k], lane, 32); }
        const size_t cidx = ((size_t)b * 128 + c) * 1024 + chg;
        float st = 0.f, At = 1.f;
#pragma unroll
        for (int k = 0; k < 8; ++k) {
            const float A0 = h == 0 ? gA[k] : pA[k], H0 = h == 0 ? gH[k] : pH[k], A1 = h == 0 ? pA[k] : gA[k], H1 = h == 0 ? pH[k] : gH[k];
            const float s0 = st; st = A0 * st + H0; const float s1 = st; st = A1 * st + H1;
            cin[k] = h == 0 ? s0 : s1; ain[k] = h == 0 ? At : At * A0; At *= A0 * A1; }
        if (h == 0 && !dry) { ((float*)(F.ws + WS_LA))[cidx] = At; ((float*)(F.ws + WS_LH))[cidx] = st; }
        bf16_t* YA = (bf16_t*)(F.ws + WS_YA) + ((size_t)b * 8192 + c * 64) * 1024 + chg;
        unsigned char* AC = (unsigned char*)(F.ws + WS_ACUM) + ((size_t)b * 8192 + c * 64) * 1024 + chg;
#pragma unroll
        for (int k = 0; k < 8; ++k) { float sv = cin[k], ac = ain[k];
#pragma unroll
            for (int e = 0; e < 4; ++e) { const int i = 4 * (k & 3) + e; const float av = ga[k >> 2][i]; sv = av * sv + gx[k >> 2][i]; ac *= av;
                const size_t ro = (size_t)(32 * (k >> 2) + crow(i, h)) * 1024;
                if (!dry) { YA[ro] = f2bf(sv); AC[ro] = (unsigned char)(int)(ac * 255.0f + 0.5f); } else asm volatile("" :: "v"(sv), "v"(ac)); } }
    }
    __syncthreads();
}
template <bool FINAL> DI void lru_units(const Frame& F, const Args& a, int l, bool dry = false) {
    if (F.vcu >= 1024) return;
    { const int lane = lane_id(); lru_stage_conv(F, a, l, F.wave * 64 + lane); }
    LruPre cur;
    lru_issue<FINAL>(cur, F.vcu, F, a, l, lane_id());
    for (int u = F.vcu; u < 1024; u += F.G) {
        LruPre nxt; const bool hn = u + F.G < 1024; const int lane = lane_id();
        if (hn) lru_issue<FINAL>(nxt, u + F.G, F, a, l, lane); else nxt = cur;
        lru_compute<FINAL>(cur, u, F, lane, dry);
        cur = nxt;
    }
}
DI float shup(float v, int lane, int d) { return __int_as_float(__builtin_amdgcn_ds_bpermute((lane - d) << 2, __float_as_int(v))); }
DI void lru2_unit(int u, const Frame& F) {
    FRAME_LT;
    const int seq = u * 8 + F.wave, ch = seq & 1023, b = seq >> 10;
    const float* LA = (const float*)(F.ws + WS_LA) + (size_t)b * 128 * 1024 + ch; const float* LH = (const float*)(F.ws + WS_LH) + (size_t)b * 128 * 1024 + ch;
    float* LC = (float*)(F.ws + WS_LC) + (size_t)b * 128 * 1024 + ch;
    const float a0 = LA[(size_t)(2 * lane) * 1024], h0 = LH[(size_t)(2 * lane) * 1024], a1 = LA[(size_t)(2 * lane + 1) * 1024], h1 = LH[(size_t)(2 * lane + 1) * 1024];
    float A = a0 * a1, H = a1 * h0 + h1;
#pragma unroll
    for (int d = 1; d < 64; d <<= 1) { const float Ap = shup(A, lane, d), Hp = shup(H, lane, d); if (lane >= d) { H = A * Hp + H; A = A * Ap; } }
    float E = shup(H, lane, 1); if (lane == 0) E = 0.f;
    LC[(size_t)(2 * lane) * 1024] = E; LC[(size_t)(2 * lane + 1) * 1024] = a0 * E + h0;
}

constexpr int N_PHASES = 17;
__global__ void __launch_bounds__(NTHR, 2) hybrid_fwd(Args args) {
    extern __shared__ __attribute__((aligned(16))) unsigned char lds_raw[];
    Frame F;
    F.lds = (LAS unsigned char*)lds_raw;
    const int wave_s = __builtin_amdgcn_readfirstlane((int)threadIdx.x >> 6);
    F.wave = wave_s;
    F.G = gridDim.x; { const int bx = blockIdx.x; F.vcu = (F.G % 8 == 0) ? (bx % 8) * (F.G / 8) + bx / 8 : bx; }
    F.ws = (GAS unsigned char*)args.ws;
    volatile LAS unsigned* MISC = (volatile LAS unsigned*)(F.lds + MISC_OFF);
    { const int tid0 = wave_s * 64 + lane_id();
      for (int u = tid0; u < (LDS_BYTES - LDSCTL_OFF) / 4; u += NTHR) ((LAS unsigned*)(F.lds + LDSCTL_OFF))[u] = 0u; }
    __syncthreads();
    XcdBarrier bar; bar.bar = (unsigned*)(F.ws + WS_CTL); bar.x = 0; bar.st = nullptr;
#if !MK_SPLIT
    bar = xcd_barrier_post((unsigned*)(F.ws + WS_CTL), MISC + 8, wave_s * 64 + lane_id());
#endif
    int lo = args.ph_lo; const int hi = args.ph_hi;
#ifndef PHMASK
#define PHMASK 0x1ff
#endif
    if (lo == 0) {
        if (PHMASK & 1) phase_pre(F, args);
        lo = 1;
#if !MK_SPLIT
        if (lo < hi) xcd_barrier(bar, wave_s * 64 + lane_id());
#endif
    }
    for (int ph = lo; ph < hi; ++ph) {
        int bx = blockIdx.x; asm volatile("" : "+s"(bx));
        { GAS unsigned char* wsl = (GAS unsigned char*)args.ws; asm volatile("" : "+s"(wsl)); F.ws = wsl; }
        {
            const int l = (ph - 1) >> 3, sub = (ph - 1) & 7;
            if (!((PHMASK >> (sub + 1)) & 1)) {}
            else if (sub == 0) { phase_norm(F, args, l); if (REP == 1) { __syncthreads(); phase_norm(F, args, l); } }
            else if (sub == 1 || sub == 5) {
                pg8::APlain ap{(const bf16_t*)(F.ws + WS_H), 1024};
                if (sub == 1) {
                    const int tid = wave_s * 64 + lane_id();
                    pg8::StaticOrder S; S.init(T, N_G1A, F.G, bx);
                    EpiG1<0> E{false, F.ws, ARGIN(args, 14) + (size_t)l * 192, ARGIN(args, 15) + (size_t)l * 192};
                    pg8::gemm_phase<EpiG1<0>, pg8::APlain, pg8::StaticOrder>(F.lds, tid, ap, (const bf16_t*)(F.ws + WS_WIN), 1024, 1024, S, E);
                    if (REP == 2) pg8::gemm_phase<EpiG1<0>, pg8::APlain, pg8::StaticOrder>(F.lds, tid, ap, (const bf16_t*)(F.ws + WS_WIN), 1024, 1024, S, E);
                } else {
                    const int tid = wave_s * 64 + lane_id();
                    pg8::StaticOrder S; S.init(T, N_G1B, F.G, bx);
                    EpiG1<1> E{false, F.ws, nullptr, nullptr};
                    pg8::gemm_phase<EpiG1<1>, pg8::APlain, pg8::StaticOrder>(F.lds, tid, ap, (const bf16_t*)(F.ws + WS_WIN) + (size_t)N_G1A * 1024, 1024, 1024, S, E);
                    if (REP == 16) { EpiG1<1> ED{true, F.ws, nullptr, nullptr}; pg8::gemm_phase<EpiG1<1>, pg8::APlain, pg8::StaticOrder>(F.lds, wave_s * 64 + lane_id(), ap, (const bf16_t*)(F.ws + WS_WIN) + (size_t)N_G1A * 1024, 1024, 1024, S, ED); }
                    if (REP == 10) { EpiNull EN; pg8::gemm_phase<EpiNull, pg8::APlain, pg8::StaticOrder>(F.lds, wave_s * 64 + lane_id(), ap, (const bf16_t*)(F.ws + WS_WIN) + (size_t)N_G1A * 1024, 1024, 1024, S, EN); }
                }
            }
            else if (sub == 2) {
                lru_units<false>(F, args, l); if (REP == 3) lru_units<false>(F, args, l);
                gla1_units(F, args, l); if (REP == 4) gla1_units(F, args, l);
                if (REP == 7) { int dry = 1; asm volatile("" : "+s"(dry)); att_units(F, dry != 0); }
                att_units(F);
            }
            else if (sub == 3) {
                for (int u = F.vcu; u < 256 + 256 + 256; u += F.G) { if (u < 256) { if (REP == 13) { int dry = 1; asm volatile("" : "+s"(dry)); gla2_unit(u, F, dry != 0); } gla2_unit(u, F); } else if (u < 512) { yb_unit(u - 256, F); if (REP == 9) yb_unit(u - 256, F); } else lru2_unit(u - 512, F); }
            }
            else if (sub == 4) {
                if (REP == 8) { int dry = 1; asm volatile("" : "+s"(dry)); gla3_units(F, args, l, dry != 0); }
                gla3_units(F, args, l);
            }
            else if (sub == 6) {
                const int tid = wave_s * 64 + lane_id();
                pg8::ASeg3 ap{(const bf16_t*)(F.ws + WS_YA), (const bf16_t*)(F.ws + WS_YB), (const bf16_t*)(F.ws + WS_YC), 1024};
                pg8::StaticOrder S; S.init(T, 1024, F.G, bx);
                EpiG2 E{F.ws};
                pg8::gemm_phase<EpiG2, pg8::ASeg3, pg8::StaticOrder>(F.lds, tid, ap, (const bf16_t*)(F.ws + WS_WP), 2560, 2560, S, E);
                if (REP == 15) pg8::gemm_phase<EpiG2, pg8::ASeg3, pg8::StaticOrder>(F.lds, wave_s * 64 + lane_id(), ap, (const bf16_t*)(F.ws + WS_WP), 2560, 2560, S, E);
                if (REP == 6) { EpiNull EN; pg8::gemm_phase<EpiNull, pg8::ASeg3, pg8::StaticOrder>(F.lds, wave_s * 64 + lane_id(), ap, (const bf16_t*)(F.ws + WS_WP), 2560, 2560, S, EN); }
            }
            else {
                const int tid = wave_s * 64 + lane_id();
                pg8::APlain ap{(const bf16_t*)(F.ws + WS_MERGED), 1024};
                pg8::StaticOrder S; S.init(T, 1024, F.G, bx);
                EpiG3 E{l == 0 ? ARGIN(args, 0) : (const float*)ARGOUT(args), ARGOUT(args), (const float*)(F.ws + WS_MODF) + (size_t)l * 2 * 3072 + 2048};
                pg8::gemm_phase<EpiG3, pg8::APlain, pg8::StaticOrder>(F.lds, tid, ap, (const bf16_t*)(F.ws + WS_WO), 1024, 1024, S, E);
                if (REP == 14 && l == 0) pg8::gemm_phase<EpiG3, pg8::APlain, pg8::StaticOrder>(F.lds, wave_s * 64 + lane_id(), ap, (const bf16_t*)(F.ws + WS_WO), 1024, 1024, S, E);
                if (REP == 12) { EpiNull EN; pg8::gemm_phase<EpiNull, pg8::APlain, pg8::StaticOrder>(F.lds, wave_s * 64 + lane_id(), ap, (const bf16_t*)(F.ws + WS_WO), 1024, 1024, S, EN); }
            }
        }
#if !MK_SPLIT
        if (ph + 1 < hi) { xcd_barrier(bar, wave_s * 64 + lane_id()); if (REP == 11) xcd_barrier(bar, wave_s * 64 + lane_id()); }
#endif
    }
}

extern "C" void kernel_launch(void* const* d_in, const int* in_sizes, int n_in, void* d_out, int out_size, void* d_ws, size_t ws_size, hipStream_t stream) {
    static int grid = 0;
    if (grid == 0) {
        if (n_in != 24 || out_size != T * DM || ws_size < WS_END) { fprintf(stderr, "kernel_launch: unexpected shapes (n_in %d, out %d, ws %zu < %zu)\n", n_in, out_size, ws_size, (size_t)WS_END); grid = -1; return; }
        int dev = 0, cus = 0, per_cu = 0;
        if (hipGetDevice(&dev) != hipSuccess || hipDeviceGetAttribute(&cus, hipDeviceAttributeMultiprocessorCount, dev) != hipSuccess) { grid = -1; return; }
        if (hipFuncSetAttribute((const void*)hybrid_fwd, hipFuncAttributeMaxDynamicSharedMemorySize, LDS_BYTES) != hipSuccess) { fprintf(stderr, "kernel_launch: hipFuncSetAttribute failed\n"); grid = -1; return; }
        if (hipOccupancyMaxActiveBlocksPerMultiprocessor(&per_cu, (const void*)hybrid_fwd, NTHR, LDS_BYTES) != hipSuccess || per_cu < 1) { fprintf(stderr, "kernel_launch: occupancy query says %d blocks/CU\n", per_cu); (void)hipGetLastError(); }
        grid = cus;
    }
    if (grid < 0) return;
    (void)hipMemsetAsync((char*)d_ws + WS_CTL, 0, CTL_ZERO_BYTES, stream);
    Args a{};
    for (int i = 0; i < 24; ++i) a.in[i] = (const float*)d_in[i];
    a.out = (float*)d_out; a.ws = (unsigned char*)d_ws;
#if MK_SPLIT
    for (int ph = 0; ph < N_PHASES; ++ph) { a.ph_lo = ph; a.ph_hi = ph + 1; hipLaunchKernelGGL(hybrid_fwd, dim3(grid), dim3(NTHR), LDS_BYTES, stream, a); }
#else
    a.ph_lo = 0; a.ph_hi = N_PHASES;
    hipLaunchKernelGGL(hybrid_fwd, dim3(grid), dim3(NTHR), LDS_BYTES, stream, a);
#endif
}
```

```cpp
#include <hip/hip_runtime.h>
#include <cstdio>
#include <cstdint>

#ifndef MK_SPLIT
#define MK_SPLIT 0
#endif
#ifndef REP
#define REP 0
#endif

#define LAS __attribute__((address_space(3)))
#define GAS __attribute__((address_space(1)))
#define DI __device__ __forceinline__
typedef _Float16 h16x2 __attribute__((ext_vector_type(2)));
typedef unsigned short bf16_t;
typedef short bf16x8 __attribute__((ext_vector_type(8)));
typedef short s16x4 __attribute__((ext_vector_type(4)));
typedef float f32x4 __attribute__((ext_vector_type(4)));
typedef float f32x2 __attribute__((ext_vector_type(2)));
typedef float f32x16 __attribute__((ext_vector_type(16)));
typedef unsigned u32x4 __attribute__((ext_vector_type(4)));
typedef unsigned u32x2 __attribute__((ext_vector_type(2)));
typedef __bf16 bf16x2_t __attribute__((ext_vector_type(2)));

constexpr int BATCH = 2, SEQ = 8192, DM = 1024, T = BATCH * SEQ;
constexpr int N_IN = 13312, N_G1A = 8192, N_G1B = 5120;
constexpr float EPS = 1e-6f;
constexpr float LOG2E = 1.4426950408889634f;

__constant__ float c_invf[32] = {
1.000000000e+00f, 7.498942018e-01f, 5.623413324e-01f, 4.216965139e-01f,
3.162277639e-01f, 2.371373773e-01f, 1.778279394e-01f, 1.333521456e-01f,
1.000000015e-01f, 7.498942316e-02f, 5.623413250e-02f, 4.216964915e-02f,
3.162277490e-02f, 2.371373773e-02f, 1.778279431e-02f, 1.333521400e-02f,
9.999999776e-03f, 7.498942316e-03f, 5.623413250e-03f, 4.216964822e-03f,
3.162277630e-03f, 2.371373819e-03f, 1.778279431e-03f, 1.333521446e-03f,
1.000000047e-03f, 7.498941850e-04f, 5.623413017e-04f, 4.216965172e-04f,
3.162277571e-04f, 2.371373703e-04f, 1.778279402e-04f, 1.333521504e-04f};

DI float bf2f(unsigned short u) { return __uint_as_float(((unsigned)u) << 16); }
DI float bflo(unsigned w) { return __uint_as_float(w << 16); }
DI float bfhi(unsigned w) { return __uint_as_float(w & 0xffff0000u); }
DI unsigned pk2(float lo, float hi) { f32x2 v = {lo, hi}; bf16x2_t b = __builtin_convertvector(v, bf16x2_t); return __builtin_bit_cast(unsigned, b); }
DI unsigned short f2bf(float f) { return (unsigned short)(pk2(f, 0.f) & 0xffffu); }
DI float sigmoidf_(float x) { return __builtin_amdgcn_rcpf(1.0f + __builtin_amdgcn_exp2f(-1.4426950408889634f * x)); }
DI float siluf_(float x) { return x * __builtin_amdgcn_rcpf(1.0f + __builtin_amdgcn_exp2f(-1.4426950408889634f * x)); }
DI int crow(int reg, int h) { return (reg & 3) + 8 * (reg >> 2) + 4 * h; }
#define MFMA32(a, b, c) __builtin_amdgcn_mfma_f32_32x32x16_bf16((a), (b), (c), 0, 0, 0)
DI float shx(float v, int lane, int m) { return __int_as_float(__builtin_amdgcn_ds_bpermute((lane ^ m) << 2, __float_as_int(v))); }
DI float wave_sum(float v, int lane) {
#pragma unroll
    for (int o = 1; o < 64; o <<= 1) v += shx(v, lane, o);
    return v;
}
DI bf16x8 pack_step(const f32x16& x, int s) {
    u32x4 p;
    p[0] = pk2(x[8 * s + 0], x[8 * s + 1]); p[1] = pk2(x[8 * s + 2], x[8 * s + 3]);
    p[2] = pk2(x[8 * s + 4], x[8 * s + 5]); p[3] = pk2(x[8 * s + 6], x[8 * s + 7]);
    return __builtin_bit_cast(bf16x8, p);
}

namespace pg8 {
#define PG8_LAS __attribute__((address_space(3)))
constexpr int BM = 256, BK = 64, HALF = 128, HTB = HALF * BK * 2, STAGE_BYTES = 8 * HTB, NXCD = 8, WGM = 8;
__host__ __device__ __forceinline__ int lds_byte(int r, int c) { const int st = (r >> 4) * 2 + (c >> 5), rr = r & 15, cc = c & 31, ob = rr * 64 + cc * 2; return st * 1024 + (ob ^ (((ob >> 9) & 1) << 5)); }
__host__ __device__ __forceinline__ void stage_rc(int b, int& R, int& C) { const int st = b / 1024, sb = b % 1024, swz = sb ^ (((sb >> 9) & 1) << 5); R = (st >> 1) * 16 + swz / 64; C = (st & 1) * 32 + (swz % 64) / 2; }
__host__ __device__ __forceinline__ int perm32(int rho) { const int n = rho >> 4, i = rho & 15; return 8 * (i >> 2) + 4 * n + (i & 3); }
struct Unit { int pm, pn; };
struct StaticOrder {
    int nM, nN, nwg, G, c;
    __host__ __device__ void init(int M, int N, int G_, int c_) { nM = M / BM; nN = N / BM; nwg = nM * nN; G = G_; c = c_; }
    __host__ __device__ bool next(int i, Unit& u) const {
        const long L = (long)i * G + c; if (L >= nwg) return false;
        int wgid = (int)L; { const int q = nwg / NXCD, r = nwg % NXCD, xcd = wgid % NXCD, off = wgid / NXCD; wgid = (xcd < r ? xcd * (q + 1) : r * (q + 1) + (xcd - r) * q) + off; }
        const int nig = WGM * nN, gid = wgid / nig, fm = gid * WGM, gsz = (nM - fm) < WGM ? (nM - fm) : WGM;
        u.pm = fm + ((wgid % nig) % gsz); u.pn = (wgid % nig) / gsz; return true;
    }
};
struct APlain { const bf16_t* A; int lda;
    DI const char* at(int pm, int t) const { return (const char*)(A + (size_t)pm * 256 * lda + (size_t)t * 64); } };
struct ABlk { const bf16_t* A; int nt; int lda;
    DI const char* at(int pm, int t) const { return (const char*)(A + ((size_t)(pm * nt + (t >> 2)) << 16) + (size_t)(t & 3) * 64); } };
struct ASeg3 { const bf16_t* A0; const bf16_t* A1; const bf16_t* A2; int lda;
    DI const char* at(int pm, int t) const { const bf16_t* base = t < 16 ? A0 + t * 64 : (t < 24 ? A1 + (t - 16) * 64 : A2 + (t - 24) * 64); return (const char*)(base + (size_t)pm * 256 * lda); } };

template <class Epi, class AP, class Sched>
__device__ __forceinline__ void gemm_phase(PG8_LAS unsigned char* lds, int tid, const AP ap, const bf16_t* Bt, int ldb, int K, const Sched& S, const Epi& E) {
    const int wid = __builtin_amdgcn_readfirstlane(tid >> 6), lane = tid & 63, wr = wid >> 2, wc = wid & 3, fr = lane & 15, fq = lane >> 4;
    const int nt = K / BK, lda = ap.lda;
    unsigned voffA[2], voffB[2];
#pragma unroll
    for (int i = 0; i < 2; ++i) { int R, C; stage_rc(tid * 16 + i * 8192, R, C); const int Rb = Epi::PERM ? (64 * (R >> 5) + perm32(R & 31)) : R;
        voffA[i] = (unsigned)(R * lda + C) * 2u; voffB[i] = (unsigned)(Rb * ldb + C) * 2u; }
    const size_t kstep = (size_t)(BK * 2);
    const size_t hstepA = (size_t)HALF * lda * 2, hstepB = (size_t)(Epi::PERM ? 32 : HALF) * ldb * 2;
    const size_t tstepB = (size_t)BM * ldb * 2;
    const unsigned ldsw = (unsigned)wid * 1024u;
    const int aoff = lds_byte(wr * 64 + fr, fq * 8), boff = lds_byte(wc * 32 + fr, fq * 8);
#define PG8_SA(b, h) (((b) * 2 + (h)) * HTB)
#define PG8_SB(b, h) ((4 + (b) * 2 + (h)) * HTB)
#define PG8_STAGE(bufoff, gbase, voff) do { _Pragma("unroll") for (int _i = 0; _i < 2; ++_i) \
        __builtin_amdgcn_global_load_lds((const unsigned*)((const char*)(gbase) + (voff)[_i]), (PG8_LAS unsigned*)(lds + (bufoff) + ldsw + _i * 8192), 16, 0, 0); } while (0)
#define PG8_LDA(dst, b, h) do { _Pragma("unroll") for (int m = 0; m < 4; ++m) _Pragma("unroll") for (int k = 0; k < 2; ++k) dst[m][k] = *(const PG8_LAS bf16x8*)(lds + PG8_SA(b, h) + aoff + m * 2048 + k * 1024); } while (0)
#define PG8_LDB(dst, b, h) do { _Pragma("unroll") for (int n = 0; n < 2; ++n) _Pragma("unroll") for (int k = 0; k < 2; ++k) dst[n][k] = *(const PG8_LAS bf16x8*)(lds + PG8_SB(b, h) + boff + n * 2048 + k * 1024); } while (0)
#define PG8_MMA(ai, bj, At, Bt_) do { __builtin_amdgcn_s_setprio(1); _Pragma("unroll") for (int m = 0; m < 4; ++m) _Pragma("unroll") for (int n = 0; n < 2; ++n) _Pragma("unroll") for (int k = 0; k < 2; ++k) \
        acc[ai][bj][m][n] = __builtin_amdgcn_mfma_f32_16x16x32_bf16(Bt_[n][k], At[m][k], acc[ai][bj][m][n], 0, 0, 0); __builtin_amdgcn_s_setprio(0); } while (0)
#define PG8_WAIT_V(n) asm volatile("s_waitcnt vmcnt(" #n ")" ::: "memory")
#define PG8_WAIT_L(n) asm volatile("s_waitcnt lgkmcnt(" #n ")" ::: "memory")
#define PG8_BAR __builtin_amdgcn_s_barrier()
#define PG8_SCHED __builtin_amdgcn_sched_barrier(0)
    Unit cur, nxt; int ui = 0;
    if (!S.next(0, cur)) return;
    f32x4 acc[2][2][4][2];
#pragma unroll
    for (int a = 0; a < 2; ++a)
#pragma unroll
        for (int b = 0; b < 2; ++b)
#pragma unroll
            for (int m = 0; m < 4; ++m)
#pragma unroll
                for (int n = 0; n < 2; ++n) acc[a][b][m][n] = (f32x4){0.f, 0.f, 0.f, 0.f};
    bf16x8 At[4][2], B0[2][2], B1[2][2];
    const char* cB = (const char*)Bt + (size_t)cur.pn * tstepB;
    {
        const char* cA0 = ap.at(cur.pm, 0); const char* cA1 = ap.at(cur.pm, 1);
        PG8_STAGE(PG8_SB(0, 0), cB, voffB); PG8_STAGE(PG8_SB(0, 1), cB + hstepB, voffB); PG8_STAGE(PG8_SA(0, 0), cA0, voffA); PG8_STAGE(PG8_SA(0, 1), cA0 + hstepA, voffA);
        if (wr == 1) PG8_BAR;
        PG8_WAIT_V(2); PG8_BAR;
        PG8_STAGE(PG8_SB(1, 0), cB + kstep, voffB); PG8_STAGE(PG8_SA(1, 0), cA1, voffA); PG8_STAGE(PG8_SB(1, 1), cB + hstepB + kstep, voffB);
        PG8_WAIT_V(6); PG8_BAR;
    }
    for (;;) {
        const bool has_next = S.next(ui + 1, nxt);
        const Unit nu = has_next ? nxt : cur;
        const char* nB = (const char*)Bt + (size_t)nu.pn * tstepB;
        for (int t = 0; t < nt; t += 2) {
            const bool last = (t == nt - 2);
            asm volatile("" : "+v"(voffA[0]), "+v"(voffA[1]), "+v"(voffB[0]), "+v"(voffB[1]));
            if constexpr (Epi::KHOOK) { E.khook(acc, cur, t, wr, wc, fr, fq); PG8_SCHED; }
            const char* a1 = ap.at(cur.pm, t + 1);
            const char* a2 = last ? ap.at(nu.pm, 0) : ap.at(cur.pm, t + 2);
            const char* a3 = last ? ap.at(nu.pm, 1) : ap.at(cur.pm, t + 3);
            const char* b2 = last ? nB : cB + (size_t)(t + 2) * kstep;
            const char* b3 = b2 + kstep;
            PG8_LDB(B0, 0, 0); PG8_LDB(B1, 0, 1); PG8_SCHED; PG8_LDA(At, 0, 0); PG8_STAGE(PG8_SA(1, 1), a1 + hstepA, voffA);
            PG8_WAIT_V(8); PG8_WAIT_L(0); PG8_BAR; PG8_MMA(0, 0, At, B0); PG8_MMA(0, 1, At, B1); PG8_BAR; PG8_SCHED;
            PG8_LDA(At, 0, 1); PG8_STAGE(PG8_SB(0, 0), b2, voffB); PG8_STAGE(PG8_SB(0, 1), b2 + hstepB, voffB); PG8_STAGE(PG8_SA(0, 0), a2, voffA);
            PG8_WAIT_V(8); PG8_WAIT_L(0); PG8_BAR; PG8_MMA(1, 0, At, B0); PG8_MMA(1, 1, At, B1); PG8_BAR; PG8_SCHED;
            PG8_LDB(B0, 1, 0); PG8_LDB(B1, 1, 1); PG8_SCHED; PG8_LDA(At, 1, 0); PG8_STAGE(PG8_SA(0, 1), a2 + hstepA, voffA);
            PG8_WAIT_V(8); PG8_WAIT_L(0); PG8_BAR; PG8_MMA(0, 0, At, B0); PG8_MMA(0, 1, At, B1); PG8_BAR; PG8_SCHED;
            PG8_LDA(At, 1, 1); PG8_STAGE(PG8_SB(1, 0), b3, voffB); PG8_STAGE(PG8_SB(1, 1), b3 + hstepB, voffB); PG8_STAGE(PG8_SA(1, 0), a3, voffA);
            PG8_WAIT_V(8); PG8_WAIT_L(0); PG8_BAR; PG8_MMA(1, 0, At, B0); PG8_MMA(1, 1, At, B1); PG8_BAR; PG8_SCHED;
        }
        if (wr == 0) PG8_BAR;
        E(acc, cur, wr, wc, fr, fq);
        if constexpr (Epi::EARLY) E.early(ui, tid);
        if (!has_next) break;
#pragma unroll
        for (int a = 0; a < 2; ++a)
#pragma unroll
            for (int b = 0; b < 2; ++b)
#pragma unroll
                for (int m = 0; m < 4; ++m)
#pragma unroll
                    for (int n = 0; n < 2; ++n) acc[a][b][m][n] = (f32x4){0.f, 0.f, 0.f, 0.f};
        cur = nxt; cB = nB; ++ui;
        if (wr == 1) PG8_BAR;
    }
    PG8_WAIT_V(0);
    PG8_BAR;
#undef PG8_SA
#undef PG8_SB
#undef PG8_STAGE
#undef PG8_LDA
#undef PG8_LDB
#undef PG8_MMA
#undef PG8_WAIT_V
#undef PG8_WAIT_L
#undef PG8_BAR
#undef PG8_SCHED
}
}

constexpr size_t MiB = 1u << 20;
constexpr size_t WS_CTL = 0, CTL_ZERO_BYTES = 64 * 1024;
constexpr size_t WS_MODF = 1 * MiB;
constexpr size_t WS_MODP = WS_MODF + 64 * 1024;
constexpr size_t WS_LRUW = 2 * MiB;
constexpr size_t WS_GDEC = WS_LRUW + 256 * 1024;
constexpr size_t WS_LR   = 3 * MiB;
constexpr size_t WS_ROPE = 4 * MiB;
constexpr size_t WS_LSE  = 8 * MiB;
constexpr size_t WS_LA   = 10 * MiB;
constexpr size_t WS_LH   = 11 * MiB;
constexpr size_t WS_LC   = 12 * MiB;
constexpr size_t WS_WO   = 13 * MiB;
constexpr size_t WS_WP   = 15 * MiB;
constexpr size_t WS_WIN  = 20 * MiB;
constexpr size_t WS_H    = 46 * MiB;
constexpr size_t WS_AX   = 78 * MiB;
constexpr size_t WS_Q    = 110 * MiB;
constexpr size_t WS_K    = 158 * MiB;
constexpr size_t WS_VT   = 206 * MiB;
constexpr size_t WS_CQ   = 254 * MiB;
constexpr size_t WS_CK   = 270 * MiB;
constexpr size_t WS_CV   = 286 * MiB;
constexpr size_t WS_YA   = 318 * MiB;
constexpr size_t WS_KV   = 350 * MiB;
constexpr size_t WS_END  = 414 * MiB;
constexpr size_t WS_MG = WS_Q, WS_YB = WS_VT, WS_MERGED = WS_AX, WS_YC = WS_CV;
constexpr size_t WS_BG = WS_KV + 32 * MiB;
constexpr size_t WS_ACUM = WS_KV + 48 * MiB;

constexpr int RING_BYTES = 131072, LDSCTL_OFF = RING_BYTES, MISC_OFF = LDSCTL_OFF + 320, LDS_BYTES = 147456;
constexpr int NWAVES = 8, NTHR = 512;

typedef GAS unsigned gu32;
#define RLX_AGENT __ATOMIC_RELAXED, __HIP_MEMORY_SCOPE_AGENT
#define XB_TMO      128
#define XB_XCNT(j)  (256  + 64 * (j))
#define XB_XSUB(j)  (1280 + 64 * (j))
#define XB_XGEN(j)  (2304 + 64 * (j))
#define XB_TOP      3328
#define XB_TOPGEN   3392
#define XCD_BAR_WORDS 3456
#define XB_SPIN_CAP (1u << 18)
DI unsigned xb_ld(unsigned* p)              { return __hip_atomic_load(p, __ATOMIC_RELAXED, __HIP_MEMORY_SCOPE_AGENT); }
DI unsigned xb_add(unsigned* p, unsigned v) { return __hip_atomic_fetch_add(p, v, __ATOMIC_RELAXED, __HIP_MEMORY_SCOPE_AGENT); }
DI unsigned xb_xcc_id() { return (unsigned)__builtin_amdgcn_s_getreg((3 << 11) | 20) & 0xFu; }
#define XB_SPIN(cond, bar) do { unsigned _sp = 0; while (cond) { __builtin_amdgcn_s_sleep(1); \
    if ((++_sp & 255u) == 0u) { if (xb_ld(&(bar)[XB_TMO])) break; if (_sp > XB_SPIN_CAP) { atomicAdd(&(bar)[XB_TMO], 1u); break; } } } } while (0)
struct XcdBarrier { unsigned* bar; unsigned x; volatile LAS unsigned* st; };
DI XcdBarrier xcd_barrier_post(unsigned* bar, volatile LAS unsigned* st, int tid) {
    XcdBarrier b; b.bar = bar; b.x = xb_xcc_id(); b.st = st;
    if (tid == 0) (void)xb_add(&bar[XB_XCNT(b.x)], 1u);
    return b;
}
DI void xcd_barrier_complete(unsigned* bar, unsigned x, unsigned& nloc, unsigned& nx) {
    const unsigned G = gridDim.x * gridDim.y * gridDim.z;
    unsigned sum, cnt, mine, sp = 0u;
    for (;;) {
        sum = 0u; cnt = 0u; mine = 0u;
#pragma unroll
        for (unsigned j = 0; j < 16; ++j) { const unsigned c = xb_ld(&bar[XB_XCNT(j)]); sum += c; cnt += (c > 0u) ? 1u : 0u; mine = (j == x) ? c : mine; }
        if (sum == G) break;
        __builtin_amdgcn_s_sleep(1);
        if ((++sp & 255u) == 0u) { if (xb_ld(&bar[XB_TMO])) break; if (sp > XB_SPIN_CAP) { atomicAdd(&bar[XB_TMO], 1u); break; } }
    }
    nloc = mine > 0u ? mine : 1u; nx = cnt > 0u ? cnt : 1u;
}
DI void xcd_barrier(const XcdBarrier& b, int tid) {
    asm volatile("s_waitcnt vmcnt(0)" ::: "memory");
    __syncthreads();
    if (tid == 0) {
        unsigned* bar = b.bar;
        __builtin_amdgcn_s_waitcnt(0);
        unsigned nloc = b.st[0], nx = b.st[1];
        if (nloc == 0u) { xcd_barrier_complete(bar, b.x, nloc, nx); b.st[0] = nloc; b.st[1] = nx; }
        const unsigned old = xb_add(&bar[XB_XSUB(b.x)], 1u);
        const unsigned gen = old / nloc;
        if (old + 1u == (gen + 1u) * nloc) {
            __builtin_amdgcn_fence(__ATOMIC_RELEASE, "agent");
            asm volatile("s_waitcnt vmcnt(0)" ::: "memory");
            const unsigned og = xb_add(&bar[XB_TOP], 1u);
            const unsigned tg = og / nx;
            if (og + 1u == (tg + 1u) * nx) xb_add(&bar[XB_TOPGEN], 1u);
            else XB_SPIN(xb_ld(&bar[XB_TOPGEN]) == tg, bar);
            __builtin_amdgcn_fence(__ATOMIC_ACQUIRE, "agent");
            xb_add(&bar[XB_XGEN(b.x)], 1u);
            asm volatile("s_waitcnt vmcnt(0)" ::: "memory");
        } else {
            XB_SPIN(xb_ld(&bar[XB_XGEN(b.x)]) == gen, bar);
            __builtin_amdgcn_fence(__ATOMIC_ACQUIRE, "agent");
            asm volatile("s_waitcnt vmcnt(0)" ::: "memory");
        }
    }
    __syncthreads();
}

DI void xcd_barrier_arrive(const XcdBarrier& b, int tid) {
    asm volatile("s_waitcnt vmcnt(0)" ::: "memory");
    __syncthreads();
    if (tid == 0) {
        unsigned* bar = b.bar;
        __builtin_amdgcn_s_waitcnt(0);
        unsigned nloc = b.st[0], nx = b.st[1];
        if (nloc == 0u) { xcd_barrier_complete(bar, b.x, nloc, nx); b.st[0] = nloc; b.st[1] = nx; }
        const unsigned old = xb_add(&bar[XB_XSUB(b.x)], 1u);
        const unsigned gen = old / nloc;
        if (old + 1u == (gen + 1u) * nloc) {
            __builtin_amdgcn_fence(__ATOMIC_RELEASE, "agent");
            asm volatile("s_waitcnt vmcnt(0)" ::: "memory");
            const unsigned og = xb_add(&bar[XB_TOP], 1u);
            const unsigned tg = og / nx;
            if (og + 1u == (tg + 1u) * nx) xb_add(&bar[XB_TOPGEN], 1u);
            else XB_SPIN(xb_ld(&bar[XB_TOPGEN]) == tg, bar);
            xb_add(&bar[XB_XGEN(b.x)], 1u);
            asm volatile("s_waitcnt vmcnt(0)" ::: "memory");
            b.st[2] = 0xffffffffu;
        } else b.st[2] = gen;
    }
}
DI void xcd_barrier_wait(const XcdBarrier& b, int tid) {
    if (tid == 0) {
        const unsigned gen = b.st[2];
        if (gen != 0xffffffffu) XB_SPIN(xb_ld(&b.bar[XB_XGEN(b.x)]) == gen, b.bar);
        __builtin_amdgcn_fence(__ATOMIC_ACQUIRE, "agent");
        asm volatile("s_waitcnt vmcnt(0)" ::: "memory");
    }
    __syncthreads();
}
constexpr int GB_BASE = 4096;
DI void group_barrier(unsigned* ctl, int slot, unsigned target, int tid) {
    asm volatile("s_waitcnt vmcnt(0)" ::: "memory");
    __syncthreads();
    if (tid == 0) {
        unsigned* w = ctl + GB_BASE + 16 * slot;
        (void)xb_add(w, 1u);
        XB_SPIN(xb_ld(w) < target, ctl);
        __builtin_amdgcn_fence(__ATOMIC_ACQUIRE, "agent");
        asm volatile("s_waitcnt vmcnt(0)" ::: "memory");
    }
    __syncthreads();
}

DI void ctr_arrive(unsigned* ctl, int slot, int tid) {
    asm volatile("s_waitcnt vmcnt(0)" ::: "memory");
    __syncthreads();
    if (tid == 0) (void)xb_add(ctl + GB_BASE + 16 * slot, 1u);
}
DI void ctr_wait(unsigned* ctl, int slot, unsigned target, int tid) {
    if (tid == 0) {
        unsigned* w = ctl + GB_BASE + 16 * slot;
        XB_SPIN(xb_ld(w) < target, ctl);
        __builtin_amdgcn_fence(__ATOMIC_ACQUIRE, "agent");
        asm volatile("s_waitcnt vmcnt(0)" ::: "memory");
    }
    __syncthreads();
}
constexpr int CS_PRE = 538;
constexpr int CS_LRU = 534, CS_GLA1 = 536;
constexpr int CS_NORM = 406;
constexpr int CS_AX = 402, CS_G1A = 404;
constexpr int CS_GLA2 = 384, CS_MIX2 = 400;

struct Args { const float* in[24]; float* out; unsigned char* ws; int ph_lo, ph_hi; };
#define ARGIN(A, i) ([&]() -> const float* { int _i = (i); asm volatile("" : "+s"(_i)); return (const float*)(const GAS float*)(A).in[_i]; }())
#define ARGOUT(A) ((float*)(GAS float*)(A).out)
struct Frame {
    LAS unsigned char* lds;
    int wave, vcu, G;
    GAS unsigned char* ws;
};
DI int lane_id() { int l; asm volatile("v_mbcnt_lo_u32_b32 %0, -1, 0\n\tv_mbcnt_hi_u32_b32 %0, -1, %0" : "=v"(l)); return l; }
#define FRAME_LT const int lane = lane_id(); const int tid = F.wave * 64 + lane; (void)tid; (void)lane

DI void phase_pre(const Frame& F, const Args& a) {
    FRAME_LT;
    const int* pos = (const int*)ARGIN(a, 2);
    h16x2* rope = (h16x2*)(F.ws + WS_ROPE);
    const int gt = F.vcu * NTHR + tid, GT = F.G * NTHR;
    for (int i = gt; i < T * 32; i += GT) {
        const int m = i >> 5, fi = i & 31;
        const float angf = (float)pos[m] * c_invf[fi];
        const double ang = (double)angf;
        const double kq = __builtin_rint(ang * 0.63661977236758134308);
        const double y = (ang - kq * 1.5707963267948966192) - kq * 6.123233995736766e-17;
        const double y2 = y * y;
        double sn = y * (1.0 + y2 * (-1.0 / 6 + y2 * (1.0 / 120 + y2 * (-1.0 / 5040 + y2 * (1.0 / 362880 + y2 * (-1.0 / 39916800 + y2 * (1.0 / 6227020800.0)))))));
        double cs = 1.0 + y2 * (-0.5 + y2 * (1.0 / 24 + y2 * (-1.0 / 720 + y2 * (1.0 / 40320 + y2 * (-1.0 / 3628800 + y2 * (1.0 / 479001600.0))))));
        const int q = ((int)kq) & 3;
        double c, s;
        if (q == 0) { c = cs; s = sn; } else if (q == 1) { c = -sn; s = cs; } else if (q == 2) { c = -cs; s = -sn; } else { c = sn; s = -cs; }
        { const h16x2 cs2 = {(_Float16)(float)c, (_Float16)(float)s}; __hip_atomic_store((unsigned*)rope + i, __builtin_bit_cast(unsigned, cs2), __ATOMIC_RELAXED, __HIP_MEMORY_SCOPE_AGENT); }
    }
    const float* cvec = ARGIN(a, 1); const float* ada_w = ARGIN(a, 3);
    float* modp = (float*)(F.ws + WS_MODP);
    for (int i = gt; i < 16 * 2 * 3072; i += GT) {
        const int j = i % 3072, l = (i / 3072) & 1, sl = i / 6144;
        float a0 = 0.f, a1 = 0.f;
        const float* w = ada_w + ((size_t)l * DM + sl * 64) * 3072 + j;
#pragma unroll 8
        for (int c = 0; c < 64; ++c) { const float wv = w[(size_t)c * 3072]; a0 += siluf_(cvec[sl * 64 + c]) * wv; a1 += siluf_(cvec[DM + sl * 64 + c]) * wv; }
        __hip_atomic_store(modp + ((sl * 2 + l) * 2 + 0) * 3072 + j, a0, __ATOMIC_RELAXED, __HIP_MEMORY_SCOPE_AGENT); __hip_atomic_store(modp + ((sl * 2 + l) * 2 + 1) * 3072 + j, a1, __ATOMIC_RELAXED, __HIP_MEMORY_SCOPE_AGENT);
    }
}

DI void st16_wt_nt(void* p, u32x4 v) { asm volatile("global_store_dwordx4 %0, %1, off sc1 nt\n\ts_nop 1" :: "v"((GAS void*)p), "v"(v) : "memory"); }
DI void st16_wt(void* p, u32x4 v) { asm volatile("global_store_dwordx4 %0, %1, off sc1\n\ts_nop 1" :: "v"((GAS void*)p), "v"(v) : "memory"); }
DI void st8_wt(void* p, unsigned long long v) { __hip_atomic_store((unsigned long long*)p, v, __ATOMIC_RELAXED, __HIP_MEMORY_SCOPE_AGENT); }
DI void dpp_pair(const u32x4 X0, const u32x4 X1, u32x4& A, u32x4& B) {
#pragma unroll
    for (int e = 0; e < 4; ++e) {
        A[e] = (unsigned)__builtin_amdgcn_update_dpp((int)X0[e], (int)X1[e], 0x128, 0xF, 0xC, false);
        B[e] = (unsigned)__builtin_amdgcn_update_dpp((int)X0[e], (int)X1[e], 0x128, 0xF, 0x3, false); }
}
DI void pair_own(const u32x4 LA, const u32x4 LB, int fr, u32x4& x0, u32x4& x1) {
    const int hi = fr >> 3;
#pragma unroll
    for (int e = 0; e < 4; ++e) { x0[e] = hi ? LB[e] : LA[e];
        const int t = __builtin_amdgcn_update_dpp((int)LA[e], (int)LA[e], 0x128, 0xF, 0x3, false);
        x1[e] = (unsigned)__builtin_amdgcn_update_dpp(t, (int)LB[e], 0x128, 0xF, 0xC, false); }
}
DI void pair_ptrs(unsigned char* rb, size_t pitch, int fr, int fq, unsigned char*& pa, unsigned char*& pb) {
    const int r7 = fr & 7, hi = fr >> 3;
    pa = rb + (size_t)r7 * pitch + (hi ? 64 : 0) + 16 * fq;
    pb = rb + (size_t)(8 + r7) * pitch + (hi ? 0 : 64) + 16 * fq;
}
DI void convert_item(const float* Wcol, int ldw, bf16_t* drow, float scale = 1.0f) {
    float v[64];
#pragma unroll
    for (int kk = 0; kk < 64; ++kk) v[kk] = __builtin_nontemporal_load(Wcol + (size_t)kk * ldw) * scale;
#pragma unroll
    for (int j = 0; j < 8; ++j) { u32x4 o; o.x = pk2(v[8 * j], v[8 * j + 1]); o.y = pk2(v[8 * j + 2], v[8 * j + 3]); o.z = pk2(v[8 * j + 4], v[8 * j + 5]); o.w = pk2(v[8 * j + 6], v[8 * j + 7]);
        *(u32x4*)(drow + 8 * j) = o; }
}
DI int win_dst_row(int n) {
    if (n < 1024) return n;
    if (n < 2048) return 8192 + (n - 1024);
    if (n < 5120) {
        const int isk = n >= 3584; const int x = n - (isk ? 3584 : 2048);
        return (isk ? 2560 : 1024) + x;
    }
    if (n < 6656) return 4096 + (n - 5120);
    if (n < 7168) return 7680 + (n - 6656);
    if (n < 7680) return 5632 + (n - 7168);
    if (n < 8192) return 6144 + (n - 7680);
    if (n < 9216) return 6656 + (n - 8192);
    if (n < 10240) return 9216 + (n - 9216);
    return n;
}
DI void phase_norm(const Frame& F, const Args& a, int l, int part = 2, bool grp = false, int sel = 0) {
    FRAME_LT;
    if (part != 1) {
        const int gw = F.vcu * NWAVES + F.wave, NGW = F.G * NWAVES;
        const float* w_in = ARGIN(a, 6) + (size_t)l * DM * N_IN;
        const float* proj_a = ARGIN(a, 20) + (size_t)l * 1024 * 1024;
        const float* proj_b = ARGIN(a, 21) + (size_t)l * 512 * 1024;
        const float* proj_c = ARGIN(a, 22) + (size_t)l * 1024 * 1024;
        const float* w_o = ARGIN(a, 23) + (size_t)l * 1024 * 1024;
        const float* lru_wa = ARGIN(a, 9) + (size_t)l * 16 * 64 * 64;
        const float* lru_wx = ARGIN(a, 11) + (size_t)l * 16 * 64 * 64;
        bf16_t* WIN = (bf16_t*)(F.ws + WS_WIN); bf16_t* WP = (bf16_t*)(F.ws + WS_WP); bf16_t* WO = (bf16_t*)(F.ws + WS_WO); bf16_t* LW = (bf16_t*)(F.ws + WS_LRUW);
        constexpr int I_IN = 16 * 208, I_PA = 16 * 16, I_PB = 8 * 16, I_PC = 16 * 16, I_WO = 16 * 16, I_LW = 32;
        constexpr int NITEMS = I_IN + I_PA + I_PB + I_PC + I_WO + I_LW;
        if (sel == 1) {
            for (int it = gw; it < 16 * 128 + I_LW; it += NGW) {
                if (it < 16 * 128) { const int kb = it >> 7, q = it & 127, cb = q < 16 ? q : q + 16, n = 64 * cb + lane;
                    convert_item(w_in + (size_t)(64 * kb) * N_IN + n, N_IN, WIN + (size_t)win_dst_row(n) * 1024 + 64 * kb); continue; }
                const int mat = it - 16 * 128, blk = mat >> 1, gate = mat & 1;
                const float* src = (gate ? lru_wx : lru_wa) + (size_t)blk * 4096;
                convert_item(src + lane, 64, LW + (size_t)(blk * 2 + gate) * 4096 + (size_t)lane * 64, -LOG2E); }
        } else if (sel == 2) {
            for (int it = gw; it < 16 * 80 + I_PA + I_PB + I_PC + I_WO; it += NGW) {
                int r = it;
                if (r < 16 * 80) { const int kb = r / 80, q = r % 80, cb = q < 16 ? 16 + q : 128 + q, n = 64 * cb + lane;
                    convert_item(w_in + (size_t)(64 * kb) * N_IN + n, N_IN, WIN + (size_t)win_dst_row(n) * 1024 + 64 * kb); continue; } r -= 16 * 80;
                if (r < I_PA) { const int kb = r / 16, n = 64 * (r % 16) + lane; convert_item(proj_a + (size_t)(64 * kb) * 1024 + n, 1024, WP + (size_t)n * 2560 + 64 * kb); continue; } r -= I_PA;
                if (r < I_PB) { const int kb = r / 16, n = 64 * (r % 16) + lane; convert_item(proj_b + (size_t)(64 * kb) * 1024 + n, 1024, WP + (size_t)n * 2560 + 1024 + 64 * kb); continue; } r -= I_PB;
                if (r < I_PC) { const int kb = r / 16, n = 64 * (r % 16) + lane; convert_item(proj_c + (size_t)(64 * kb) * 1024 + n, 1024, WP + (size_t)n * 2560 + 1536 + 64 * kb); continue; } r -= I_PC;
                { const int kb = r / 16, n = 64 * (r % 16) + lane; convert_item(w_o + (size_t)(64 * kb) * 1024 + n, 1024, WO + (size_t)n * 1024 + 64 * kb); } }
        } else
        for (int it = gw; it < NITEMS; it += NGW) {
            int r = it;
            if (r < I_IN) { const int kb = r / 208, n = 64 * (r % 208) + lane; convert_item(w_in + (size_t)(64 * kb) * N_IN + n, N_IN, WIN + (size_t)win_dst_row(n) * 1024 + 64 * kb); continue; } r -= I_IN;
            if (r < I_PA) { const int kb = r / 16, n = 64 * (r % 16) + lane; convert_item(proj_a + (size_t)(64 * kb) * 1024 + n, 1024, WP + (size_t)n * 2560 + 64 * kb); continue; } r -= I_PA;
            if (r < I_PB) { const int kb = r / 16, n = 64 * (r % 16) + lane; convert_item(proj_b + (size_t)(64 * kb) * 1024 + n, 1024, WP + (size_t)n * 2560 + 1024 + 64 * kb); continue; } r -= I_PB;
            if (r < I_PC) { const int kb = r / 16, n = 64 * (r % 16) + lane; convert_item(proj_c + (size_t)(64 * kb) * 1024 + n, 1024, WP + (size_t)n * 2560 + 1536 + 64 * kb); continue; } r -= I_PC;
            if (r < I_WO) { const int kb = r / 16, n = 64 * (r % 16) + lane; convert_item(w_o + (size_t)(64 * kb) * 1024 + n, 1024, WO + (size_t)n * 1024 + 64 * kb); continue; } r -= I_WO;
            { const int mat = r, blk = mat >> 1, gate = mat & 1;
              const float* src = (gate ? lru_wx : lru_wa) + (size_t)blk * 4096;
              convert_item(src + lane, 64, LW + (size_t)(blk * 2 + gate) * 4096 + (size_t)lane * 64, -LOG2E); }
        }
    }
    if (part == 0) return;
    __syncthreads();
    LAS float* sh = (LAS float*)(F.lds);
    LAS float* sc = (LAS float*)(F.lds + 8192);
    LAS float* a1T = (LAS float*)(F.lds + 16384);
    {
        const float* modp = (const float*)(F.ws + WS_MODP); const float* ada_b = ARGIN(a, 4) + (size_t)l * 3072;
        float* modf = (float*)(F.ws + WS_MODF);
        for (int i = tid; i < 2 * 2048; i += NTHR) {
            const int b = i >> 11, j = i & 2047; float s = ada_b[j];
#pragma unroll
            for (int sl = 0; sl < 16; ++sl) s += modp[((sl * 2 + l) * 2 + b) * 3072 + j];
            if (j < 1024) sh[b * 1024 + j] = s; else sc[b * 1024 + (j - 1024)] = s;
        }
        const int gt = F.vcu * NTHR + tid;
        if (gt < 2 * 3072) { const int b = gt / 3072, j = gt % 3072; float s = ada_b[j];
#pragma unroll
            for (int sl = 0; sl < 16; ++sl) s += modp[((sl * 2 + l) * 2 + b) * 3072 + j];
            modf[(l * 2 + b) * 3072 + j] = s; }
        const float* a1 = ARGIN(a, 16) + (size_t)l * 1024 * 16;
        for (int i = tid; i < 16384; i += NTHR) { const int c = i >> 4, r = i & 15; a1T[r * 1024 + c] = a1[i]; }
    }
    __syncthreads();
    {
        const float* xin = l == 0 ? ARGIN(a, 0) : (const float*)ARGOUT(a);
        const float* ng = ARGIN(a, 5) + (size_t)l * 1024;
        bf16_t* H = (bf16_t*)(F.ws + WS_H); float* LR = (float*)(F.ws + WS_LR);
        const int gw = F.vcu * NWAVES + F.wave, NGW = F.G * NWAVES;
        f32x4 gv[4];
#pragma unroll
        for (int j = 0; j < 4; ++j) gv[j] = *(const f32x4*)(ng + 4 * lane + 256 * j);
        f32x4 nv[4];
        const int m0 = grp ? (8 * (F.vcu >> 5) + (F.vcu & 7)) * 256 + ((F.vcu & 31) >> 3) * 64 + F.wave * 8 : gw;
        const int mstep = grp ? 1 : NGW, mend = grp ? m0 + 8 : T;
        if (m0 < mend) { const f32x4* xr = (const f32x4*)(xin + (size_t)m0 * DM) + lane;
#pragma unroll
            for (int j = 0; j < 4; ++j) nv[j] = __builtin_nontemporal_load(xr + 64 * j); }
        for (int m = m0; m < mend; m += mstep) {
            const int b = m >> 13;
            f32x4 v[4]; float ss = 0.f;
#pragma unroll
            for (int j = 0; j < 4; ++j) { v[j] = nv[j]; ss += (v[j].x * v[j].x + v[j].y * v[j].y) + (v[j].z * v[j].z + v[j].w * v[j].w); }
            if (m + mstep < mend) { const f32x4* xr = (const f32x4*)(xin + (size_t)(m + mstep) * DM) + lane;
#pragma unroll
                for (int j = 0; j < 4; ++j) nv[j] = __builtin_nontemporal_load(xr + 64 * j); }
            const float rinv = __builtin_amdgcn_rsqf(wave_sum(ss, lane) * (1.f / DM) + EPS);
            float lr[16];
#pragma unroll
            for (int r = 0; r < 16; ++r) lr[r] = 0.f;
            unsigned long long* o8 = (unsigned long long*)(H + (size_t)m * DM) + lane;
#pragma unroll
            for (int j = 0; j < 4; ++j) {
                const int c0 = 4 * lane + 256 * j;
                const f32x4 scv = *(const LAS f32x4*)(sc + b * 1024 + c0), shv = *(const LAS f32x4*)(sh + b * 1024 + c0);
                f32x4 hv;
#pragma unroll
                for (int e = 0; e < 4; ++e) hv[e] = v[j][e] * rinv * gv[j][e] * (1.0f + scv[e]) + shv[e];
                st8_wt(o8 + 64 * j, (unsigned long long)pk2(hv.x, hv.y) | ((unsigned long long)pk2(hv.z, hv.w) << 32));
#pragma unroll
                for (int r = 0; r < 16; ++r) { const f32x4 av = *(const LAS f32x4*)(a1T + r * 1024 + c0); lr[r] += (hv.x * av.x + hv.y * av.y) + (hv.z * av.z + hv.w * av.w);
                    if ((r & 3) == 3) asm volatile("" ::: "memory"); }
            }
            float a8[8], a4[4], a2[2], a1v;
            { const bool up = (lane & 32) != 0;
#pragma unroll
              for (int r = 0; r < 8; ++r) { const float keep = up ? lr[r + 8] : lr[r], send = up ? lr[r] : lr[r + 8]; a8[r] = keep + shx(send, lane, 32); } }
            { const bool up = (lane & 16) != 0;
#pragma unroll
              for (int r = 0; r < 4; ++r) { const float keep = up ? a8[r + 4] : a8[r], send = up ? a8[r] : a8[r + 4]; a4[r] = keep + shx(send, lane, 16); } }
            { const bool up = (lane & 8) != 0;
#pragma unroll
              for (int r = 0; r < 2; ++r) { const float keep = up ? a4[r + 2] : a4[r], send = up ? a4[r] : a4[r + 2]; a2[r] = keep + shx(send, lane, 8); } }
            { const bool up = (lane & 4) != 0; const float keep = up ? a2[1] : a2[0], send = up ? a2[0] : a2[1]; a1v = keep + shx(send, lane, 4); }
            a1v += shx(a1v, lane, 2); a1v += shx(a1v, lane, 1);
            if ((lane & 3) == 0) __hip_atomic_store(LR + (size_t)m * 16 + (lane >> 2), a1v, __ATOMIC_RELAXED, __HIP_MEMORY_SCOPE_AGENT);
        }
    }
}

template <int mode> struct EpiG1 {
    static constexpr bool PERM = true, KHOOK = false;
    static constexpr bool EARLY = (mode == 0);
    bool dry;
    GAS unsigned char* ws; const float* qn_g; const float* kn_g;
    unsigned* early_ctr;
    DI void early(int ui, int tid) const {
        if (ui != 0 || early_ctr == nullptr) return;
        asm volatile("s_waitcnt vmcnt(0)" ::: "memory");
        __syncthreads();
        if (tid == 0) (void)xb_add(early_ctr, 1u);
    }
    DI void store_plain(const f32x4 (&acc)[2][2][4][2], bf16_t* base, int ldc, int colw, int rowb, int fr, int fq, float sc) const {
#pragma unroll
        for (int ai = 0; ai < 2; ++ai)
#pragma unroll
            for (int m = 0; m < 4; ++m) {
                u32x4 x[2];
#pragma unroll
                for (int bj = 0; bj < 2; ++bj) { const f32x4 v0 = acc[ai][bj][m][0] * sc, v1 = acc[ai][bj][m][1] * sc;
                    x[bj].x = pk2(v0[0], v0[1]); x[bj].y = pk2(v0[2], v0[3]); x[bj].z = pk2(v1[0], v1[1]); x[bj].w = pk2(v1[2], v1[3]); }
                u32x4 A, B; dpp_pair(x[0], x[1], A, B);
                unsigned char *pa, *pb; pair_ptrs((unsigned char*)(base + (size_t)(rowb + ai * 128 + m * 16) * ldc + colw), (size_t)ldc * 2, fr, fq, pa, pb);
                st16_wt_nt(pa, A); st16_wt_nt(pb, B); }
    }
    DI void operator()(f32x4 (&acc)[2][2][4][2], const pg8::Unit& u, int wr, int wc, int, int) const {
        const int ln_ = lane_id(), fr = ln_ & 15, fq = ln_ >> 4;
        const int pn = u.pn, rowb = u.pm * 256 + wr * 64, row0 = rowb + fr, cw = wc * 64 + 8 * fq;
        if (mode == 0) {
            if (pn < 4) { store_plain(acc, (bf16_t*)(ws + WS_AX), 1024, pn * 256 + 64 * wc, rowb, fr, fq, 1.0f); }
            else if (pn < 16) {
                const bool isk = pn >= 10; const int t6 = pn - (isk ? 10 : 4), g = t6 >> 1;
                bf16_t* base = (bf16_t*)(ws + (isk ? WS_K : WS_Q));
                const float* gn = (isk ? kn_g : qn_g) + g * 64;
                const float sc = isk ? 1.0f : 0.125f * LOG2E;
                const u32x4* rope = (const u32x4*)(ws + WS_ROPE);
                u32x4 rp[2][4][2];
#pragma unroll
                for (int m = 0; m < 4; ++m) { const u32x4* p = rope + (size_t)(row0 + m * 16) * 8 + 2 * fq; rp[0][m][0] = p[0]; rp[0][m][1] = p[1]; }
                f32x4 g0[2], g1[2];
#pragma unroll
                for (int n = 0; n < 2; ++n) { g0[n] = *(const f32x4*)(gn + 8 * fq + 4 * n); g1[n] = *(const f32x4*)(gn + 32 + 8 * fq + 4 * n); }
#pragma unroll
                for (int ai = 0; ai < 2; ++ai)
#pragma unroll
                    for (int m = 0; m < 4; ++m) {
                        const int row = row0 + ai * 128 + m * 16;
                        if (ai == 0) { const u32x4* p = rope + (size_t)(row + 128) * 8 + 2 * fq; rp[1][m][0] = p[0]; rp[1][m][1] = p[1]; }
                        float ss = 0.f;
#pragma unroll
                        for (int bj = 0; bj < 2; ++bj)
#pragma unroll
                            for (int n = 0; n < 2; ++n) { const f32x4 x = acc[ai][bj][m][n]; ss += (x[0] * x[0] + x[1] * x[1]) + (x[2] * x[2] + x[3] * x[3]); }
                        ss += shx(ss, fq * 16 + fr, 16); ss += shx(ss, fq * 16 + fr, 32);
                        const float rinv = __builtin_amdgcn_rsqf(ss * (1.f / 64.f) + EPS) * sc;
                        u32x4 w1, w2;
#pragma unroll
                        for (int n = 0; n < 2; ++n) {
                            const u32x4 cw4 = rp[ai][m][n];
                            const f32x4 y1 = acc[ai][0][m][n] * rinv * g0[n], y2 = acc[ai][1][m][n] * rinv * g1[n];
                            float a[4], b[4];
#pragma unroll
                            for (int e = 0; e < 4; ++e) { const unsigned wv = cw4[e]; const h16x2 cs = __builtin_bit_cast(h16x2, wv);   const float c = (float)cs[0], sn = (float)cs[1];
                                a[e] = y1[e] * c - y2[e] * sn; b[e] = y2[e] * c + y1[e] * sn; }
                            w1[2 * n] = pk2(a[0], a[1]); w1[2 * n + 1] = pk2(a[2], a[3]); w2[2 * n] = pk2(b[0], b[1]); w2[2 * n + 1] = pk2(b[2], b[3]);
                        }
                        { u32x4 A, B; dpp_pair(w1, w2, A, B); unsigned char *pa, *pb;
                          pair_ptrs((unsigned char*)(base + (size_t)(rowb + ai * 128 + m * 16) * 1536 + t6 * 256 + 64 * wc), 3072, fr, fq, pa, pb); st16_wt_nt(pa, A); st16_wt_nt(pb, B); }
                        asm volatile("" ::: "memory");
                    }
            }
            else if (pn < 22) { store_plain(acc, (bf16_t*)(ws + WS_VT), 1536, (pn - 16) * 256 + 64 * wc, rowb, fr, fq, 1.0f); }
            else if (pn < 24) { store_plain(acc, (bf16_t*)(ws + WS_CQ), 512, (pn - 22) * 256 + 64 * wc, rowb, fr, fq, 0.08838834764831845f); }
            else if (pn < 26) { store_plain(acc, (bf16_t*)(ws + WS_CK), 512, (pn - 24) * 256 + 64 * wc, rowb, fr, fq, 1.0f); }
            else if (pn < 30) { store_plain(acc, (bf16_t*)(ws + WS_CV), 1024, (pn - 26) * 256 + 64 * wc, rowb, fr, fq, 1.0f); }
            else {
                bf16_t* BG = (bf16_t*)(ws + WS_BG);
#pragma unroll
                for (int ai = 0; ai < 2; ++ai)
#pragma unroll
                    for (int m = 0; m < 4; ++m) {
                        u32x4 x[2];
#pragma unroll
                        for (int bj = 0; bj < 2; ++bj) { const f32x4 v0 = acc[ai][bj][m][0], v1 = acc[ai][bj][m][1];
                            x[bj].x = pk2(siluf_(v0[0]), siluf_(v0[1])); x[bj].y = pk2(siluf_(v0[2]), siluf_(v0[3])); x[bj].z = pk2(siluf_(v1[0]), siluf_(v1[1])); x[bj].w = pk2(siluf_(v1[2]), siluf_(v1[3])); }
                        u32x4 A, B; dpp_pair(x[0], x[1], A, B); unsigned char *pa, *pb;
                        pair_ptrs((unsigned char*)(BG + (size_t)(rowb + ai * 128 + m * 16) * 512 + (pn - 30) * 256 + 64 * wc), 1024, fr, fq, pa, pb); st16_wt_nt(pa, A); st16_wt_nt(pb, B); }
            }
        } else {
            if (pn < 8) {
                bf16_t* Y; int col0;
                if (pn < 4) { Y = (bf16_t*)(ws + WS_YA); col0 = pn * 256; } else { Y = (bf16_t*)(ws + WS_YC); col0 = (pn - 4) * 256; }
                const bool isa = pn < 4;
#pragma unroll
                for (int ai = 0; ai < 2; ++ai)
#pragma unroll
                    for (int bj = 0; bj < 2; ++bj)
#pragma unroll
                        for (int m = 0; m < 4; ++m)
#pragma unroll
                            for (int n = 0; n < 2; ++n) asm volatile("" : "+v"(acc[ai][bj][m][n]));
                const unsigned char* AC = (const unsigned char*)(ws + WS_ACUM);
                const float* LC = (const float*)(ws + WS_LC);
                u32x4 yv[8][2]; u32x2 av[8][2]; f32x4 lc[2][2][2];
                auto ld_item = [&](int i) { const size_t ro = (size_t)(row0 + (i >> 2) * 128 + (i & 3) * 16) * 1024 + col0 + cw;
                    { unsigned char *qa, *qb; pair_ptrs((unsigned char*)(Y + (size_t)(rowb + (i >> 2) * 128 + (i & 3) * 16) * 1024 + col0 + 64 * wc), 2048, fr, fq, qa, qb);
                      yv[i][0] = *(const u32x4*)qa; yv[i][1] = *(const u32x4*)qb; }
#pragma unroll
                    for (int bj = 0; bj < 2; ++bj) av[i][bj] = isa ? *(const u32x2*)(AC + ro + bj * 32) : (u32x2){0u, 0u}; };
                auto ld_lc = [&](int ai) {
#pragma unroll
                    for (int bj = 0; bj < 2; ++bj)
#pragma unroll
                        for (int n = 0; n < 2; ++n) lc[ai][bj][n] = isa ? *(const f32x4*)(LC + (size_t)(u.pm * 4 + ai * 2 + wr) * 1024 + col0 + cw + bj * 32 + 4 * n) * (1.0f / 255.0f) : (f32x4){0.f, 0.f, 0.f, 0.f}; };
                ld_lc(0); ld_item(0); ld_item(1);
#pragma unroll
                for (int i = 0; i < 8; ++i) { const int ai = i >> 2, m = i & 3;
                    if (i + 2 < 8) ld_item(i + 2);
                    if (i == 2) ld_lc(1);
                    u32x4 x[2], yo[2]; pair_own(yv[i][0], yv[i][1], fr, yo[0], yo[1]);
#pragma unroll
                    for (int bj = 0; bj < 2; ++bj) { const u32x4 y = yo[bj]; const u32x2 q = av[i][bj]; const f32x4 v0 = acc[ai][bj][m][0], v1 = acc[ai][bj][m][1], c0 = lc[ai][bj][0], c1 = lc[ai][bj][1];
                        u32x4& w = x[bj];
                        w.x = pk2((bflo(y.x) + (float)(q.x & 255u) * c0[0]) * siluf_(v0[0]), (bfhi(y.x) + (float)((q.x >> 8) & 255u) * c0[1]) * siluf_(v0[1]));
                        w.y = pk2((bflo(y.y) + (float)((q.x >> 16) & 255u) * c0[2]) * siluf_(v0[2]), (bfhi(y.y) + (float)(q.x >> 24) * c0[3]) * siluf_(v0[3]));
                        w.z = pk2((bflo(y.z) + (float)(q.y & 255u) * c1[0]) * siluf_(v1[0]), (bfhi(y.z) + (float)((q.y >> 8) & 255u) * c1[1]) * siluf_(v1[1]));
                        w.w = pk2((bflo(y.w) + (float)((q.y >> 16) & 255u) * c1[2]) * siluf_(v1[2]), (bfhi(y.w) + (float)(q.y >> 24) * c1[3]) * siluf_(v1[3]));
                    }
                    if (!dry) { u32x4 A, B; dpp_pair(x[0], x[1], A, B); unsigned char *pa, *pb;
                        pair_ptrs((unsigned char*)(Y + (size_t)(rowb + ai * 128 + m * 16) * 1024 + col0 + 64 * wc), 2048, fr, fq, pa, pb); st16_wt(pa, A); st16_wt(pb, B); }
                    asm volatile("" ::: "memory"); }
            } else {
                unsigned char* MG8 = (unsigned char*)(ws + WS_MG) + ((size_t)(u.pm * 12 + (pn - 8)) << 16) + fr * 64 + 16 * fq;
#pragma unroll
                for (int ai = 0; ai < 2; ++ai)
#pragma unroll
                    for (int m = 0; m < 4; ++m) {
                        u32x4 wv;
#pragma unroll
                        for (int bj = 0; bj < 2; ++bj) { const f32x4 v0 = acc[ai][bj][m][0], v1 = acc[ai][bj][m][1];
                            unsigned w0 = 0u, w1 = 0u;
#pragma unroll
                            for (int e = 0; e < 4; ++e) { w0 = __builtin_amdgcn_cvt_pk_u8_f32(fmaxf(sigmoidf_(v0[e]) * 255.0f, 1.0f), e, w0); w1 = __builtin_amdgcn_cvt_pk_u8_f32(fmaxf(sigmoidf_(v1[e]) * 255.0f, 1.0f), e, w1); }
                            wv[2 * bj] = w0; wv[2 * bj + 1] = w1; }
                        st16_wt(MG8 + (size_t)(((wr * 4 + ai * 8 + m) * 4 + wc) * 1024), wv); }
            }
        }
    }
};

struct EpiG2 {
    static constexpr bool PERM = true, KHOOK = true, EARLY = false;
    GAS unsigned char* ws;
    DI void scale(f32x4 (&acc)[2][2][4][2], const pg8::Unit& u, int wr, int wc, int, int, int brn, int brd) const {
        const int ln_ = lane_id(), fr = ln_ & 15, fq = ln_ >> 4;
        const unsigned char* MG8 = (const unsigned char*)(ws + WS_MG);
        const unsigned char* tn = MG8 + ((size_t)(u.pm * 12 + brn * 4 + u.pn) << 16) + fr * 64 + 16 * fq;
        const unsigned char* td = MG8 + ((size_t)(u.pm * 12 + (brd < 0 ? 0 : brd) * 4 + u.pn) << 16) + fr * 64 + 16 * fq;
#pragma unroll
        for (int ai = 0; ai < 2; ++ai) {
            u32x2 nn[4][2], dd[4][2];
#pragma unroll
            for (int m = 0; m < 4; ++m) { const size_t off = (size_t)(((wr * 4 + ai * 8 + m) * 4 + wc) * 1024);
                const u32x4 n4 = *(const u32x4*)(tn + off); nn[m][0] = (u32x2){n4.x, n4.y}; nn[m][1] = (u32x2){n4.z, n4.w};
                if (brd >= 0) { const u32x4 d4 = *(const u32x4*)(td + off); dd[m][0] = (u32x2){d4.x, d4.y}; dd[m][1] = (u32x2){d4.z, d4.w}; } else { dd[m][0] = (u32x2){0u, 0u}; dd[m][1] = (u32x2){0u, 0u}; } }
#pragma unroll
            for (int m = 0; m < 4; ++m)
#pragma unroll
                for (int bj = 0; bj < 2; ++bj) {
                    const u32x2 n2 = nn[m][bj];
                    float r[8] = {(float)(n2.x & 255u), (float)((n2.x >> 8) & 255u), (float)((n2.x >> 16) & 255u), (float)(n2.x >> 24), (float)(n2.y & 255u), (float)((n2.y >> 8) & 255u), (float)((n2.y >> 16) & 255u), (float)(n2.y >> 24)};
                    if (brd >= 0) { const u32x2 d2 = dd[m][bj];
                        const float d[8] = {(float)(d2.x & 255u), (float)((d2.x >> 8) & 255u), (float)((d2.x >> 16) & 255u), (float)(d2.x >> 24), (float)(d2.y & 255u), (float)((d2.y >> 8) & 255u), (float)((d2.y >> 16) & 255u), (float)(d2.y >> 24)};
#pragma unroll
                        for (int e = 0; e < 8; ++e) r[e] = r[e] * __builtin_amdgcn_rcpf(d[e]); }
                    else {
#pragma unroll
                        for (int e = 0; e < 8; ++e) r[e] *= (1.0f / 255.0f); }
#pragma unroll
                    for (int e = 0; e < 4; ++e) { acc[ai][bj][m][0][e] *= r[e]; acc[ai][bj][m][1][e] *= r[4 + e]; }
                }
            asm volatile("" ::: "memory");
        }
    }
    DI void khook(f32x4 (&acc)[2][2][4][2], const pg8::Unit& u, int t, int wr, int wc, int fr, int fq) const {
        if (t == 16 || t == 24) { const int brn = (t == 16) ? 0 : 1; scale(acc, u, wr, wc, fr, fq, brn, brn + 1); }
    }
    DI void operator()(f32x4 (&acc)[2][2][4][2], const pg8::Unit& u, int wr, int wc, int, int) const {
        scale(acc, u, wr, wc, 0, 0, 2, -1);
        const int ln_ = lane_id(), fr = ln_ & 15, fq = ln_ >> 4;
        bf16_t* O = (bf16_t*)(ws + WS_MERGED);
        const int rowb = u.pm * 256 + wr * 64;
#pragma unroll
        for (int ai = 0; ai < 2; ++ai)
#pragma unroll
            for (int m = 0; m < 4; ++m) {
                u32x4 x[2];
#pragma unroll
                for (int bj = 0; bj < 2; ++bj) { const f32x4 v0 = acc[ai][bj][m][0], v1 = acc[ai][bj][m][1];
                    x[bj].x = pk2(v0[0], v0[1]); x[bj].y = pk2(v0[2], v0[3]); x[bj].z = pk2(v1[0], v1[1]); x[bj].w = pk2(v1[2], v1[3]); }
                u32x4 A, B; dpp_pair(x[0], x[1], A, B); unsigned char *pa, *pb;
                pair_ptrs((unsigned char*)(O + ((size_t)(u.pm * 4 + u.pn) << 16) + (size_t)(wr * 64 + ai * 128 + m * 16) * 256 + 64 * wc), 512, fr, fq, pa, pb); st16_wt(pa, A); st16_wt(pb, B); }
    }
};

struct EpiNull {
    static constexpr bool PERM = true, KHOOK = false, EARLY = false;
    DI void operator()(f32x4 (&acc)[2][2][4][2], const pg8::Unit&, int, int, int, int) const {
#pragma unroll
        for (int ai = 0; ai < 2; ++ai)
#pragma unroll
            for (int bj = 0; bj < 2; ++bj)
#pragma unroll
                for (int m = 0; m < 4; ++m)
#pragma unroll
                    for (int n = 0; n < 2; ++n) asm volatile("" :: "v"(acc[ai][bj][m][n]));
    }
};
struct EpiG3 {
    static constexpr bool PERM = false, KHOOK = false, EARLY = false;
    const float* xin; float* out; const float* gate;
    int last;
    DI void operator()(f32x4 (&acc)[2][2][4][2], const pg8::Unit& u, int wr, int wc, int, int) const {
        const int ln_ = lane_id(), fr = ln_ & 15, fq = ln_ >> 4;
        const int row0 = u.pm * 256 + wr * 64 + fr, col0 = u.pn * 256 + wc * 32 + 4 * fq, b = (u.pm * 256) >> 13;
        f32x4 gv[2][2];
#pragma unroll
        for (int bj = 0; bj < 2; ++bj)
#pragma unroll
            for (int n = 0; n < 2; ++n) gv[bj][n] = *(const f32x4*)(gate + b * 3072 + col0 + bj * 128 + n * 16);
        const int rowb = u.pm * 256 + wr * 64, hi = fr >> 3;
#pragma unroll
        for (int ai = 0; ai < 2; ++ai)
#pragma unroll
            for (int m = 0; m < 4; ++m)
#pragma unroll
                for (int bj = 0; bj < 2; ++bj) {
                    const size_t ib = (size_t)(rowb + ai * 128 + m * 16) * 1024 + u.pn * 256 + bj * 128 + wc * 32;
                    unsigned char *pa, *pb, *qa, *qb;
                    pair_ptrs((unsigned char*)(const_cast<float*>(xin) + ib), 4096, fr, fq, qa, qb);
                    pair_ptrs((unsigned char*)(out + ib), 4096, fr, fq, pa, pb);
                    const u32x4 LA = __builtin_nontemporal_load((const u32x4*)qa), LB = __builtin_nontemporal_load((const u32x4*)qb);
                    u32x4 x0, x1;
#pragma unroll
                    for (int e = 0; e < 4; ++e) { x0[e] = hi ? LB[e] : LA[e];
                        const int t = __builtin_amdgcn_update_dpp((int)LA[e], (int)LA[e], 0x128, 0xF, 0x3, false);
                        x1[e] = (unsigned)__builtin_amdgcn_update_dpp(t, (int)LB[e], 0x128, 0xF, 0xC, false); }
                    const f32x4 r0 = __builtin_bit_cast(f32x4, x0) + gv[bj][0] * acc[ai][bj][m][0], r1 = __builtin_bit_cast(f32x4, x1) + gv[bj][1] * acc[ai][bj][m][1];
                    u32x4 A, B; dpp_pair(__builtin_bit_cast(u32x4, r0), __builtin_bit_cast(u32x4, r1), A, B);
                    if (last) { __builtin_nontemporal_store(A, (u32x4*)pa); __builtin_nontemporal_store(B, (u32x4*)pb); } else { *(u32x4*)pa = A; *(u32x4*)pb = B; } }
    }
};

DI u32x4 widen_pair(u32x2 ev, u32x2 od) {
    const auto rx = __builtin_amdgcn_permlane32_swap(ev.x, od.x, false, false);
    const auto ry = __builtin_amdgcn_permlane32_swap(ev.y, od.y, false, false);
    u32x4 w; w.x = rx[0]; w.y = ry[0]; w.z = rx[1]; w.w = ry[1]; return w;
}
typedef short v4i16_t __attribute__((ext_vector_type(4)));
DI s16x4 tr_read(const LAS void* p) { return __builtin_bit_cast(s16x4, __builtin_amdgcn_ds_read_tr16_b64_v4i16((LAS v4i16_t*)p)); }
constexpr int AT_PITCH = 144, AT_VP = 192, AT_K = 0, AT_V = 384 * AT_PITCH;
struct AttPre { u32x4 k[6], v[6]; bf16x8 qf[4]; };
DI void att_decode(int ub, int& g, int& b, int& hh, int& dsh, int& r, int& m0) {
    const int x8 = ub & 31; hh = (ub >> 5) & 7; b = (ub >> 8) & 1; g = ub >> 9;
    dsh = 2 * g; r = x8 >> (5 - dsh); const int cb = x8 & ((32 >> dsh) - 1); m0 = 256 * cb;
}
DI void att_issue(AttPre& p, int ub, const Frame& F, int lane) {
    const int tid = F.wave * 64 + lane;
    const bf16_t* Qb = (const bf16_t*)(F.ws + WS_Q); const bf16_t* Kb = (const bf16_t*)(F.ws + WS_K); const bf16_t* Vb = (const bf16_t*)(F.ws + WS_VT);
    int g, b, hh, dsh, r, m0; att_decode(ub, g, b, hh, dsh, r, m0);
    const int colb = g * 512 + hh * 64;
#pragma unroll
    for (int i = 0; i < 6; ++i) {
        const int c = tid + NTHR * i, j = c >> 3, ch = c & 7, ci = m0 - 128 + j;
        if (ci >= 0) { const size_t off = ((size_t)b * 8192 + ((size_t)ci << dsh) + r) * 1536 + colb + 8 * ch; p.k[i] = __builtin_nontemporal_load((const u32x4*)(Kb + off)); p.v[i] = __builtin_nontemporal_load((const u32x4*)(Vb + off)); }
    }
    const int ql = lane & 31, h = lane >> 5;
    const size_t tokq = (size_t)b * 8192 + ((size_t)(m0 + 32 * F.wave + ql) << dsh) + r;
    const bf16_t* qp = Qb + tokq * 1536 + colb + 8 * h;
#pragma unroll
    for (int kk = 0; kk < 4; ++kk) p.qf[kk] = *(const bf16x8*)(qp + 16 * kk);
}
DI void att_computeA(const AttPre& p, int ub, const Frame& F, int lane) {
    const int tid = F.wave * 64 + lane;
    int g, b, hh, dsh, r, m0; att_decode(ub, g, b, hh, dsh, r, m0);
    LAS unsigned char* Kl = F.lds + AT_K; LAS unsigned char* Vl = F.lds + AT_V;
#pragma unroll
    for (int i = 0; i < 6; ++i) {
        const int c = tid + NTHR * i, j = c >> 3, ch = c & 7, ci = m0 - 128 + j;
        if (ci >= 0) { *(LAS u32x4*)(Kl + j * AT_PITCH + ch * 16) = p.k[i]; *(LAS u32x4*)(Vl + j * AT_VP + ch * 16) = p.v[i]; }
    }
    __syncthreads();
}
DI void att_computeB(const bf16x8 (&qf)[4], int ub, const Frame& F, int lane, bool dry) {
    bf16_t* Qb = (bf16_t*)(F.ws + WS_Q); float* LSE = (float*)(F.ws + WS_LSE);
    int g, b, hh, dsh, r, m0; att_decode(ub, g, b, hh, dsh, r, m0);
    const int colb = g * 512 + hh * 64;
    LAS unsigned char* Kl = F.lds + AT_K; LAS unsigned char* Vl = F.lds + AT_V;
    const int w = F.wave, ql = lane & 31, h = lane >> 5;
    const int mq = m0 + 32 * w + ql;
    const size_t tokq = (size_t)b * 8192 + ((size_t)mq << dsh) + r;
    f32x16 st[5];
    float l = 0.f;
    f32x16 zero16;
#pragma unroll
    for (int i = 0; i < 16; ++i) zero16[i] = 0.f;
#pragma unroll
    for (int kt = 0; kt < 5; ++kt) {
        const int jr = 32 * w + 32 * kt;
        if (m0 - 128 + jr >= 0) {
            const LAS unsigned char* kp = Kl + (jr + ql) * AT_PITCH + 16 * h;
            f32x16 acc = MFMA32(*(const LAS bf16x8*)(kp), qf[0], zero16);
#pragma unroll
            for (int kk = 1; kk < 4; ++kk) { const bf16x8 kf = *(const LAS bf16x8*)(kp + 32 * kk); acc = MFMA32(kf, qf[kk], acc); }
#pragma unroll
            for (int i = 0; i < 16; ++i) {
                float p = __builtin_amdgcn_exp2f(acc[i]);
                if (kt == 0) { if (crow(i, h) < ql) p = 0.f; }
                if (kt == 4) { if (crow(i, h) > ql) p = 0.f; }
                acc[i] = p; l += p; }
            st[kt] = acc;
        } else st[kt] = zero16;
    }
    l += shx(l, lane, 32);
    f32x16 o[2];
#pragma unroll
    for (int i = 0; i < 16; ++i) { o[0][i] = 0.f; o[1][i] = 0.f; }
    const int G = lane >> 4, i16 = lane & 15;
    const LAS unsigned char* vl = Vl + (4 * (G >> 1) + (i16 >> 2)) * AT_VP + (16 * (G & 1) + 4 * (i16 & 3)) * 2;
#pragma unroll
    for (int kt = 0; kt < 5; ++kt) {
        const int jr = 32 * w + 32 * kt;
        if (m0 - 128 + jr >= 0) {
#pragma unroll
            for (int s = 0; s < 2; ++s) {
                const bf16x8 pb = pack_step(st[kt], s);
#pragma unroll
                for (int db = 0; db < 2; ++db) {
                    const LAS unsigned char* vp = vl + (jr + 16 * s) * AT_VP + 64 * db;
                    const s16x4 lo = tr_read(vp), hi = tr_read(vp + 8 * AT_VP);
                    const bf16x8 va = __builtin_shufflevector(lo, hi, 0, 1, 2, 3, 4, 5, 6, 7);
                    o[db] = MFMA32(va, pb, o[db]);
                }
            }
        }
    }
    const float inv = __builtin_amdgcn_rcpf(l);
    bf16_t* op = Qb + tokq * 1536 + colb + 8 * h;
#pragma unroll
    for (int db = 0; db < 2; ++db)
#pragma unroll
        for (int pq = 0; pq < 2; ++pq) {
            u32x2 ev, od;
            ev.x = pk2(o[db][8 * pq] * inv, o[db][8 * pq + 1] * inv); ev.y = pk2(o[db][8 * pq + 2] * inv, o[db][8 * pq + 3] * inv);
            od.x = pk2(o[db][8 * pq + 4] * inv, o[db][8 * pq + 5] * inv); od.y = pk2(o[db][8 * pq + 6] * inv, o[db][8 * pq + 7] * inv);
            const u32x4 wv = widen_pair(ev, od);
            if (!dry) *(u32x4*)(op + 32 * db + 16 * pq) = wv;
        }
    if (h == 0 && !dry) LSE[(tokq * 3 + g) * 8 + hh] = __builtin_amdgcn_logf(l);
    __syncthreads();
}
DI void att_units(const Frame& F, bool dry = false) {
    if (F.vcu >= 1536) return;
    AttPre cur;
    att_issue(cur, F.vcu, F, lane_id());
    for (int ub = F.vcu; ub < 1536; ub += F.G) {
        const int lane = lane_id();
        att_computeA(cur, ub, F, lane);
        bf16x8 qf[4];
#pragma unroll
        for (int kk = 0; kk < 4; ++kk) qf[kk] = cur.qf[kk];
        if (ub + F.G < 1536) att_issue(cur, ub + F.G, F, lane);
        att_computeB(qf, ub, F, lane, dry);
    }
}

DI void yb_unit(int u, const Frame& F) {
    FRAME_LT;
    const bf16_t* O = (const bf16_t*)(F.ws + WS_Q); const float* LSE = (const float*)(F.ws + WS_LSE); bf16_t* YB = (bf16_t*)(F.ws + WS_YB);
#pragma unroll
    for (int i = 0; i < 8; ++i) {
        const int it = tid + NTHR * i; const size_t tok = (size_t)u * 64 + (it >> 6); const int c8 = it & 63, hs = c8 >> 3, d0 = (c8 & 7) * 8;
        const float l0 = LSE[(tok * 3 + 0) * 8 + hs], l1 = LSE[(tok * 3 + 1) * 8 + hs], l2 = LSE[(tok * 3 + 2) * 8 + hs];
        const float mx = fmaxf(l0, fmaxf(l1, l2));
        float w0 = __builtin_amdgcn_exp2f(l0 - mx), w1 = __builtin_amdgcn_exp2f(l1 - mx), w2 = __builtin_amdgcn_exp2f(l2 - mx);
        const float inv = __builtin_amdgcn_rcpf(w0 + w1 + w2); w0 *= inv; w1 *= inv; w2 *= inv;
        const bf16_t* op = O + tok * 1536 + hs * 64 + d0;
        const u32x4 a = __builtin_nontemporal_load((const u32x4*)(op)), bq = __builtin_nontemporal_load((const u32x4*)(op + 512)), c = __builtin_nontemporal_load((const u32x4*)(op + 1024));
        const u32x4 gt = __builtin_nontemporal_load((const u32x4*)((const bf16_t*)(F.ws + WS_BG) + tok * 512 + hs * 64 + d0));
        u32x4 w;
        w.x = pk2((w0 * bflo(a.x) + w1 * bflo(bq.x) + w2 * bflo(c.x)) * bflo(gt.x), (w0 * bfhi(a.x) + w1 * bfhi(bq.x) + w2 * bfhi(c.x)) * bfhi(gt.x));
        w.y = pk2((w0 * bflo(a.y) + w1 * bflo(bq.y) + w2 * bflo(c.y)) * bflo(gt.y), (w0 * bfhi(a.y) + w1 * bfhi(bq.y) + w2 * bfhi(c.y)) * bfhi(gt.y));
        w.z = pk2((w0 * bflo(a.z) + w1 * bflo(bq.z) + w2 * bflo(c.z)) * bflo(gt.z), (w0 * bfhi(a.z) + w1 * bfhi(bq.z) + w2 * bfhi(c.z)) * bfhi(gt.z));
        w.w = pk2((w0 * bflo(a.w) + w1 * bflo(bq.w) + w2 * bflo(c.w)) * bflo(gt.w), (w0 * bfhi(a.w) + w1 * bfhi(bq.w) + w2 * bfhi(c.w)) * bfhi(gt.w));
        st16_wt_nt(YB + tok * 1024 + hs * 64 + d0, w);
    }
}

struct GlaPre1 { u32x4 rk[2], v[4]; f32x4 lr; };
struct GlaPre3 { u32x4 rq[2], rk[2], v[4]; f32x4 lr; };
constexpr int G_W = 116736, G_WB = G_W + 8192, G_ONG = G_WB + 512;
DI void gla_stage_w(const Frame& F, int hd, const Args& a, int l, int tid) {
    const float* a2 = ARGIN(a, 17) + (size_t)l * 16 * 512; const float* ab = ARGIN(a, 18) + (size_t)l * 512; const float* ong = ARGIN(a, 19) + (size_t)l * 256;
    LAS float* W = (LAS float*)(F.lds + G_W); LAS float* WB = (LAS float*)(F.lds + G_WB); LAS float* ONG = (LAS float*)(F.lds + G_ONG);
    for (int i = tid; i < 2048; i += NTHR) W[i] = a2[(i >> 7) * 512 + hd * 128 + (i & 127)];
    if (tid < 128) WB[tid] = ab[hd * 128 + tid];
    if (tid < 256) ONG[tid] = ong[tid];
    __syncthreads();
}
template <class PRE, bool P3> DI void gla_issue(PRE& p, int bh, int n, const Frame& F, int lane) {
    const int tid = F.wave * 64 + lane;
    const int b = bh >> 2, hd = bh & 3;
    const bf16_t* CK = (const bf16_t*)(F.ws + WS_CK); const bf16_t* CV = (const bf16_t*)(F.ws + WS_CV);
    const size_t tok0 = (size_t)b * 8192 + n * 64;
#pragma unroll
    for (int i = 0; i < 2; ++i) { const int c = tid + NTHR * i, s = c >> 4, kd0 = (c & 15) * 8; const u32x4* kp = (const u32x4*)(CK + (tok0 + s) * 512 + hd * 128 + kd0); p.rk[i] = P3 ? __builtin_nontemporal_load(kp) : *kp; }
#pragma unroll
    for (int i = 0; i < 4; ++i) { const int c = tid + NTHR * i, s = c >> 5, vd0 = (c & 31) * 8; p.v[i] = *(const u32x4*)(CV + (tok0 + s) * 1024 + hd * 256 + vd0); }
    p.lr = *(const f32x4*)((const float*)(F.ws + WS_LR) + tok0 * 16 + 4 * (tid & 255));
    if constexpr (P3) {
        const bf16_t* CQ = (const bf16_t*)(F.ws + WS_CQ);
#pragma unroll
        for (int i = 0; i < 2; ++i) { const int c = tid + NTHR * i, s = c >> 4, kd0 = (c & 15) * 8; p.rq[i] = __builtin_nontemporal_load((const u32x4*)(CQ + (tok0 + s) * 512 + hd * 128 + kd0)); }
    }
}
DI void gla_cumsum(LAS float* Bc, LAS float* tot, LAS float* lrt, const f32x4 lrv, const LAS float* W, const LAS float* WB, int tid) {
    const int kd = tid & 127, part = tid >> 7;
    if (tid < 256) *(LAS f32x4*)(lrt + 4 * tid) = lrv;
    float w[16];
#pragma unroll
    for (int r = 0; r < 16; ++r) w[r] = W[r * 128 + kd];
    const float bias = WB[kd];
    __syncthreads();
    float runs[16]; float run = 0.f;
#pragma unroll
    for (int sb = 0; sb < 16; sb += 4) {
        f32x4 v[4][4];
#pragma unroll
        for (int jj = 0; jj < 4; ++jj)
#pragma unroll
            for (int q = 0; q < 4; ++q) v[jj][q] = *(const LAS f32x4*)(lrt + (part * 16 + sb + jj) * 16 + 4 * q);
        float la[4];
#pragma unroll
        for (int jj = 0; jj < 4; ++jj) {
            float pre = bias;
#pragma unroll
            for (int q = 0; q < 4; ++q) { const f32x4 x = v[jj][q]; pre += (x[0] * w[4 * q] + x[1] * w[4 * q + 1]) + (x[2] * w[4 * q + 2] + x[3] * w[4 * q + 3]); }
            la[jj] = (fminf(pre, 0.f) - 0.6931471805599453f * __builtin_amdgcn_logf(1.0f + __builtin_amdgcn_exp2f(-LOG2E * fabsf(pre)))) * (1.0f / 16.0f);
        }
#pragma unroll
        for (int jj = 0; jj < 4; ++jj) { run += la[jj]; runs[sb + jj] = run; }
    }
    tot[part * 128 + kd] = run;
    __syncthreads();
    float off = 0.f;
#pragma unroll
    for (int q = 0; q < 3; ++q) if (q < part) off += tot[q * 128 + kd];
#pragma unroll
    for (int s = 0; s < 16; ++s) Bc[(part * 16 + s) * 128 + kd] = runs[s] + off;
    __syncthreads();
}
constexpr int G_BC = 0, G_TOT = 32768, G_LRT = 34816, G_A = 38912;
constexpr int KP = 272, KPT = 320, VP = 576;
constexpr int G1_KE = G_A, G1_VL = G1_KE + 64 * KPT;
constexpr int G3_QD = G_A, G3_KI = G3_QD + 64 * KP, G3_VL = G3_KI + 64 * KP, G3_SSQ = G3_VL + 64 * VP;
template <class PRE> DI void gla_store_v(LAS unsigned char* VL, const PRE& p, int tid) {
#pragma unroll
    for (int i = 0; i < 4; ++i) { const int c = tid + NTHR * i, s = c >> 5, vd0 = (c & 31) * 8; *(LAS u32x4*)(VL + s * VP + vd0 * 2) = p.v[i]; }
}
DI int tr_lane_off(int lane, int P, int hsel) { const int G = lane >> 4, i16 = lane & 15; return (hsel * (G >> 1) + (i16 >> 2)) * P + (16 * (G & 1) + 4 * (i16 & 3)) * 2; }
DI void gla1_computeA(const GlaPre1& p, float& Dp, const Frame& F, int lane) {
    const int tid = F.wave * 64 + lane;
    LAS float* Bc = (LAS float*)(F.lds + G_BC); LAS float* tot = (LAS float*)(F.lds + G_TOT); LAS float* lrt = (LAS float*)(F.lds + G_LRT);
    LAS unsigned char* KE = F.lds + G1_KE; LAS unsigned char* VL = F.lds + G1_VL;
    gla_store_v(VL, p, tid);
    gla_cumsum(Bc, tot, lrt, p.lr, (const LAS float*)(F.lds + G_W), (const LAS float*)(F.lds + G_WB), tid);
    if (tid < 128) { const float d = __expf(Bc[63 * 128 + tid]); tot[tid] = d; Dp *= d; }
#pragma unroll
    for (int i = 0; i < 2; ++i) { const int c = tid + NTHR * i, s = c >> 4, kd0 = (c & 15) * 8;
        const unsigned wv[4] = {p.rk[i].x, p.rk[i].y, p.rk[i].z, p.rk[i].w};
        u32x4 o;
#pragma unroll
        for (int e = 0; e < 4; ++e) { const float f0 = __expf(Bc[63 * 128 + kd0 + 2 * e] - Bc[s * 128 + kd0 + 2 * e]), f1 = __expf(Bc[63 * 128 + kd0 + 2 * e + 1] - Bc[s * 128 + kd0 + 2 * e + 1]);
            o[e] = pk2(bflo(wv[e]) * f0, bfhi(wv[e]) * f1); }
        *(LAS u32x4*)(KE + s * KPT + kd0 * 2) = o; }
    __syncthreads();
}
DI void gla1_computeB(f32x16 (&S)[4], bool first, const Frame& F, int lane) {
    LAS unsigned char* KE = F.lds + G1_KE; LAS unsigned char* VL = F.lds + G1_VL; const LAS float* Bc = (const LAS float*)(F.lds + G_TOT);
    const int h = lane >> 5, w = F.wave;
    const LAS unsigned char* vbase = VL + tr_lane_off(lane, VP, 8) + 32 * w * 2;
    const LAS unsigned char* kbase = KE + tr_lane_off(lane, KPT, 8);
    bf16x8 vb[4];
#pragma unroll
    for (int kk = 0; kk < 4; ++kk) { const s16x4 lo = tr_read(vbase + 16 * kk * VP), hi = tr_read(vbase + (16 * kk + 4) * VP); vb[kk] = __builtin_shufflevector(lo, hi, 0, 1, 2, 3, 4, 5, 6, 7); }
#pragma unroll
    for (int mt = 0; mt < 4; ++mt) {
        if (first) {
#pragma unroll
            for (int i = 0; i < 16; ++i) S[mt][i] = 0.f;
        } else {
#pragma unroll
            for (int gq = 0; gq < 4; ++gq) { const f32x4 dl = *(const LAS f32x4*)(Bc + 32 * mt + 8 * gq + 4 * h);
#pragma unroll
                for (int e = 0; e < 4; ++e) S[mt][4 * gq + e] *= dl[e]; }
        }
#pragma unroll
        for (int kk = 0; kk < 4; ++kk) { const s16x4 lo = tr_read(kbase + 16 * kk * KPT + 64 * mt), hi = tr_read(kbase + (16 * kk + 4) * KPT + 64 * mt);
            const bf16x8 ka = __builtin_shufflevector(lo, hi, 0, 1, 2, 3, 4, 5, 6, 7); S[mt] = MFMA32(ka, vb[kk], S[mt]); }
    }
    __syncthreads();
}
DI void gla2_unit(int u, const Frame& F, bool dry = false) {
    FRAME_LT;
    const int gid = u * NTHR + tid, bh = gid >> 14, fi = (gid & 16383) * 2;
    const int within = fi & 4095, mtgp = within >> 9, ln = (within >> 3) & 63, sub = within & 7;
    const int kd = 32 * (mtgp >> 1) + 8 * ((mtgp & 1) * 2 + (sub >> 2)) + 4 * (ln >> 5) + (sub & 3);
    unsigned* p = (unsigned*)((bf16_t*)(F.ws + WS_KV) + (size_t)bh * 32 * 32768 + fi);
    const f32x2* dp = (const f32x2*)((const float*)(F.ws + WS_GDEC) + (size_t)bh * 32 * 128 + kd);
    unsigned cur[32]; f32x2 dc[32];
#pragma unroll
    for (int g = 0; g < 32; ++g) { cur[g] = p[(size_t)g * 16384]; dc[g] = dp[(size_t)g * 64]; }
    float s0 = 0.f, s1 = 0.f; asm volatile("" : "+v"(s0), "+v"(s1));
#pragma unroll
    for (int g = 0; g < 32; ++g) { if (!dry) __hip_atomic_store(p + (size_t)g * 16384, pk2(s0, s1), __ATOMIC_RELAXED, __HIP_MEMORY_SCOPE_AGENT);
        s0 = dc[g].x * s0 + bflo(cur[g]); s1 = dc[g].y * s1 + bfhi(cur[g]); }
}
DI void gla3_computeA(const GlaPre3& p, const Frame& F, int lane) {
    const int tid = F.wave * 64 + lane;
    LAS float* Bc = (LAS float*)(F.lds + G_BC); LAS float* tot = (LAS float*)(F.lds + G_TOT); LAS float* lrt = (LAS float*)(F.lds + G_LRT);
    LAS unsigned char* QD = F.lds + G3_QD; LAS unsigned char* KI = F.lds + G3_KI; LAS unsigned char* VL = F.lds + G3_VL;
    gla_store_v(VL, p, tid);
    gla_cumsum(Bc, tot, lrt, p.lr, (const LAS float*)(F.lds + G_W), (const LAS float*)(F.lds + G_WB), tid);
#pragma unroll
    for (int i = 0; i < 2; ++i) { const int c = tid + NTHR * i, s = c >> 4, kd0 = (c & 15) * 8;
        const unsigned wq[4] = {p.rq[i].x, p.rq[i].y, p.rq[i].z, p.rq[i].w}, wk[4] = {p.rk[i].x, p.rk[i].y, p.rk[i].z, p.rk[i].w};
        u32x4 oq, ok;
#pragma unroll
        for (int e = 0; e < 4; ++e) { const float b0 = Bc[s * 128 + kd0 + 2 * e], b1 = Bc[s * 128 + kd0 + 2 * e + 1];
            oq[e] = pk2(bflo(wq[e]) * __expf(b0), bfhi(wq[e]) * __expf(b1)); ok[e] = pk2(bflo(wk[e]) * __expf(-b0), bfhi(wk[e]) * __expf(-b1)); }
        *(LAS u32x4*)(QD + s * KP + kd0 * 2) = oq; *(LAS u32x4*)(KI + s * KP + kd0 * 2) = ok; }
    if (tid < 128) tot[tid] = __expf(Bc[63 * 128 + tid]);
    __syncthreads();
}
DI void gla3_computeB(f32x16 (&P)[4], bool last, int bh, int n, const Frame& F, int lane, bool dry) {
    const int b = bh >> 2, hd = bh & 3;
    LAS unsigned char* QD = F.lds + G3_QD; LAS unsigned char* KI = F.lds + G3_KI; LAS unsigned char* VL = F.lds + G3_VL;
    LAS float* SSQ = (LAS float*)(F.lds + G3_SSQ);
    const __amdgpu_buffer_rsrc_t yc_rs = __builtin_amdgcn_make_buffer_rsrc((void*)(F.ws + WS_CV), 0, 32 << 20, 0x00020000);
    const size_t tok0 = (size_t)b * 8192 + n * 64;
    const int ql = lane & 31, h = lane >> 5, w = F.wave;
    f32x16 at00, at01, at11;
#pragma unroll
    for (int i = 0; i < 16; ++i) { at00[i] = 0.f; at01[i] = 0.f; at11[i] = 0.f; }
    const LAS unsigned char* kr = KI + ql * KP + 16 * h; const LAS unsigned char* qr = QD + ql * KP + 16 * h;
#pragma unroll
    for (int kk = 0; kk < 8; ++kk) {
        const bf16x8 k0 = *(const LAS bf16x8*)(kr + 32 * kk), k1 = *(const LAS bf16x8*)(kr + 32 * KP + 32 * kk);
        const bf16x8 q0 = *(const LAS bf16x8*)(qr + 32 * kk), q1 = *(const LAS bf16x8*)(qr + 32 * KP + 32 * kk);
        at00 = MFMA32(k0, q0, at00); at01 = MFMA32(k0, q1, at01); at11 = MFMA32(k1, q1, at11);
    }
#pragma unroll
    for (int i = 0; i < 16; ++i) { const int s = crow(i, h); if (s > ql) { at00[i] = 0.f; at11[i] = 0.f; } }
    f32x16 o[2];
#pragma unroll
    for (int i = 0; i < 16; ++i) { o[0][i] = 0.f; o[1][i] = 0.f; }
    const LAS unsigned char* vbase = VL + tr_lane_off(lane, VP, 4) + 32 * w * 2;
#pragma unroll
    for (int s = 0; s < 2; ++s) {
        { const s16x4 lo = tr_read(vbase + (16 * s) * VP), hi = tr_read(vbase + (16 * s + 8) * VP);
          const bf16x8 va = __builtin_shufflevector(lo, hi, 0, 1, 2, 3, 4, 5, 6, 7);
          o[0] = MFMA32(va, pack_step(at00, s), o[0]); o[1] = MFMA32(va, pack_step(at01, s), o[1]); }
        { const s16x4 lo = tr_read(vbase + (32 + 16 * s) * VP), hi = tr_read(vbase + (32 + 16 * s + 8) * VP);
          const bf16x8 va = __builtin_shufflevector(lo, hi, 0, 1, 2, 3, 4, 5, 6, 7);
          o[1] = MFMA32(va, pack_step(at11, s), o[1]); }
    }
#pragma unroll
    for (int mt = 0; mt < 4; ++mt)
#pragma unroll
        for (int s = 0; s < 2; ++s) {
            const bf16x8 pa = pack_step(P[mt], s);
            const LAS unsigned char* q0p = QD + ql * KP + (32 * mt + 16 * s + 4 * h) * 2;
            const s16x4 a0 = *(const LAS s16x4*)(q0p), a1 = *(const LAS s16x4*)(q0p + 16), b0 = *(const LAS s16x4*)(q0p + 32 * KP), b1 = *(const LAS s16x4*)(q0p + 32 * KP + 16);
            o[0] = MFMA32(pa, __builtin_shufflevector(a0, a1, 0, 1, 2, 3, 4, 5, 6, 7), o[0]);
            o[1] = MFMA32(pa, __builtin_shufflevector(b0, b1, 0, 1, 2, 3, 4, 5, 6, 7), o[1]);
        }
    if (!last) {
        const LAS float* DEC = (const LAS float*)(F.lds + G_TOT);
        const LAS unsigned char* vnb = VL + tr_lane_off(lane, VP, 8) + 32 * w * 2;
        const LAS unsigned char* kib = KI + tr_lane_off(lane, KP, 8);
        bf16x8 vbn[4];
#pragma unroll
        for (int kk = 0; kk < 4; ++kk) { const s16x4 lo = tr_read(vnb + 16 * kk * VP), hi = tr_read(vnb + (16 * kk + 4) * VP); vbn[kk] = __builtin_shufflevector(lo, hi, 0, 1, 2, 3, 4, 5, 6, 7); }
#pragma unroll
        for (int mt = 0; mt < 4; ++mt) {
#pragma unroll
            for (int kk = 0; kk < 4; ++kk) { const s16x4 lo = tr_read(kib + 16 * kk * KP + 64 * mt), hi = tr_read(kib + (16 * kk + 4) * KP + 64 * mt);
                P[mt] = MFMA32(__builtin_shufflevector(lo, hi, 0, 1, 2, 3, 4, 5, 6, 7), vbn[kk], P[mt]); }
#pragma unroll
            for (int gq = 0; gq < 4; ++gq) { const f32x4 dl = *(const LAS f32x4*)(DEC + 32 * mt + 8 * gq + 4 * h);
#pragma unroll
                for (int e = 0; e < 4; ++e) P[mt][4 * gq + e] *= dl[e]; }
        }
    }
#pragma unroll
    for (int qt = 0; qt < 2; ++qt) { float ss = 0.f;
#pragma unroll
        for (int i = 0; i < 16; ++i) ss += o[qt][i] * o[qt][i];
        ss += shx(ss, lane, 32);
        if (h == 0) SSQ[w * 64 + 32 * qt + ql] = ss; }
    __syncthreads();
#pragma unroll
    for (int qt = 0; qt < 2; ++qt) {
        float ss = 0.f;
#pragma unroll
        for (int ww = 0; ww < 8; ++ww) ss += SSQ[ww * 64 + 32 * qt + ql];
        const float rinv = __builtin_amdgcn_rsqf(ss * (1.f / 256.f) + EPS);
        const unsigned dsto = (unsigned)(((tok0 + 32 * qt + ql) * 1024 + hd * 256 + 32 * w + 8 * h) * 2);
#pragma unroll
        for (int pq = 0; pq < 2; ++pq) {
            const f32x4 ge = *(const LAS f32x4*)(F.lds + G_ONG + (32 * w + 16 * pq + 4 * h) * 4), go = *(const LAS f32x4*)(F.lds + G_ONG + (32 * w + 16 * pq + 8 + 4 * h) * 4);
            u32x2 ev, od;
            ev.x = pk2(o[qt][8 * pq] * rinv * ge[0], o[qt][8 * pq + 1] * rinv * ge[1]); ev.y = pk2(o[qt][8 * pq + 2] * rinv * ge[2], o[qt][8 * pq + 3] * rinv * ge[3]);
            od.x = pk2(o[qt][8 * pq + 4] * rinv * go[0], o[qt][8 * pq + 5] * rinv * go[1]); od.y = pk2(o[qt][8 * pq + 6] * rinv * go[2], o[qt][8 * pq + 7] * rinv * go[3]);
            const u32x4 wv = widen_pair(ev, od);
            if (!dry) __builtin_amdgcn_raw_buffer_store_b128(wv, yc_rs, dsto + 32 * pq, 0, 16); }
    }
    __syncthreads();
}
DI void gla1_units(const Frame& F, const Args& a, int l) {
    for (int su = F.vcu; su < 256; su += F.G) {
        const int bh = su & 7, g = su >> 3;
        GlaPre1 cur, nxt;
        gla_issue<GlaPre1, false>(cur, bh, 4 * g, F, lane_id());
        { const int lane = lane_id(); gla_stage_w(F, bh & 3, a, l, F.wave * 64 + lane); }
        f32x16 S[4]; float Dp = 1.f;
        for (int i = 0; i < 4; ++i) {
            const int lane = lane_id();
            if (i < 3) gla_issue<GlaPre1, false>(nxt, bh, 4 * g + i + 1, F, lane);
            gla1_computeA(cur, Dp, F, lane);
            gla1_computeB(S, i == 0, F, lane);
            if (i < 3) cur = nxt;
        }
        const int lane = lane_id();
        const __amdgpu_buffer_rsrc_t gs_rs = __builtin_amdgcn_make_buffer_rsrc((void*)(F.ws + WS_KV), 0, 32 << 20, 0x00020000);
        const unsigned gso = (unsigned)((((size_t)(bh * 32 + g) * 8 + F.wave) * 4096 + lane * 8) * 2);
#pragma unroll
        for (int mt = 0; mt < 4; ++mt)
#pragma unroll
            for (int gp = 0; gp < 2; ++gp) { u32x4 sv;
                sv.x = pk2(S[mt][8 * gp], S[mt][8 * gp + 1]); sv.y = pk2(S[mt][8 * gp + 2], S[mt][8 * gp + 3]); sv.z = pk2(S[mt][8 * gp + 4], S[mt][8 * gp + 5]); sv.w = pk2(S[mt][8 * gp + 6], S[mt][8 * gp + 7]);
                __builtin_amdgcn_raw_buffer_store_b128(sv, gs_rs, gso + (unsigned)((mt * 2 + gp) * 1024), 0, 16 | 2); }
        if (F.wave * 64 + lane < 128) __hip_atomic_store((float*)(F.ws + WS_GDEC) + (size_t)(bh * 32 + g) * 128 + F.wave * 64 + lane, Dp, __ATOMIC_RELAXED, __HIP_MEMORY_SCOPE_AGENT);
    }
}
DI void gla3_units(const Frame& F, const Args& a, int l, bool dry = false) {
    for (int su0 = F.vcu; su0 < 256; su0 += F.G) {
        int su = su0;
        if (F.G == 256) {
            const int x = su0 >> 5, j = su0 & 31, pm = 8 * x + (j & 7), q = j >> 3;
            su = ((pm >> 5) * 4 + q) + 8 * (pm & 31); }
        const int bh = su & 7, g = su >> 3;
        GlaPre3 cur;
        f32x16 P[4];
        gla_issue<GlaPre3, true>(cur, bh, 4 * g, F, lane_id());
        { const int lane = lane_id(); gla_stage_w(F, bh & 3, a, l, F.wave * 64 + lane); }
        { const int lane = lane_id();
          const bf16_t* GS = (const bf16_t*)(F.ws + WS_KV) + ((size_t)(bh * 32 + g) * 8 + F.wave) * 4096 + lane * 8;
#pragma unroll
          for (int mt = 0; mt < 4; ++mt)
#pragma unroll
              for (int gp = 0; gp < 2; ++gp) { const u32x4 v = __builtin_nontemporal_load((const u32x4*)(GS + (mt * 2 + gp) * 512));
#pragma unroll
                  for (int e = 0; e < 4; ++e) { P[mt][8 * gp + 2 * e] = bflo(v[e]); P[mt][8 * gp + 2 * e + 1] = bfhi(v[e]); } } }
        for (int i = 0; i < 4; ++i) {
            const int lane = lane_id();
            gla3_computeA(cur, F, lane);
            if (i < 3) gla_issue<GlaPre3, true>(cur, bh, 4 * g + i + 1, F, lane);
            gla3_computeB(P, i == 3, bh, 4 * g + i, F, lane, dry);
        }
    }
}

DI float fsigmoid(float x) { return __builtin_amdgcn_rcpf(1.0f + __builtin_amdgcn_exp2f(-LOG2E * x)); }
constexpr int LX_PITCH = 528;
constexpr int L_XC2 = 57344;
constexpr int L_YST = 57344, L_AST = 91136, L_AP = 272;
constexpr int L_CW = 34816, L_CB = L_CW + 16384;
struct LruPre { u32x4 raw[7]; bf16x8 wa[4], wx[4]; float ba, bx, lam; };
template <bool FINAL> DI void lru_issue(LruPre& p, int u, const Frame& F, const Args& a, int l, int lane) {
    const int tid = F.wave * 64 + lane;
    const int cg = u & 3, c = (u >> 2) & 127, b = u >> 9, ch0 = cg * 256;
    const bf16_t* AX = (const bf16_t*)(F.ws + WS_AX);
    const int cc = (tid & 31) * 8, t0 = c * 64 + 4 * (tid >> 5) - 3;
#pragma unroll
    for (int j = 0; j < 7; ++j) { const int tt = t0 + j;
        if (tt >= 0) p.raw[j] = __builtin_nontemporal_load((const u32x4*)(AX + ((size_t)b * 8192 + tt) * 1024 + ch0 + cc)); else p.raw[j] = (u32x4){0u, 0u, 0u, 0u}; }
    const int w = F.wave, bl = w >> 1, nt = w & 1, ql = lane & 31, h = lane >> 5;
    const bf16_t* LW = (const bf16_t*)(F.ws + WS_LRUW) + (size_t)((cg * 4 + bl) * 2) * 4096 + (32 * nt + ql) * 64 + 8 * h;
#pragma unroll
    for (int kk = 0; kk < 4; ++kk) { p.wa[kk] = *(const bf16x8*)(LW + 16 * kk); p.wx[kk] = *(const bf16x8*)(LW + 4096 + 16 * kk); }
    const int chg = ch0 + bl * 64 + 32 * nt + ql;
    p.ba = -LOG2E * ARGIN(a, 10)[(size_t)l * 1024 + chg]; p.bx = -LOG2E * ARGIN(a, 12)[(size_t)l * 1024 + chg]; p.lam = ARGIN(a, 13)[(size_t)l * 1024 + chg];
}
DI void lru_stage_conv(const Frame& F, const Args& a, int l, int tid) {
    const float* cw = ARGIN(a, 7) + (size_t)l * 4 * 1024; const float* cb = ARGIN(a, 8) + (size_t)l * 1024;
    LAS float* CW = (LAS float*)(F.lds + L_CW); LAS float* CB = (LAS float*)(F.lds + L_CB);
    for (int i = tid; i < 1024; i += NTHR) { *(LAS f32x4*)(CW + 4 * i) = *(const f32x4*)(cw + 4 * i); }
    if (tid < 256) *(LAS f32x4*)(CB + 4 * tid) = *(const f32x4*)(cb + 4 * tid);
    __syncthreads();
}
template <bool FINAL> DI void lru_compute(const LruPre& p, int u, const Frame& F, int lane, bool dry, int par) {
    const int tid = F.wave * 64 + lane;
    const int cg = u & 3, c = (u >> 2) & 127, b = u >> 9, ch0 = cg * 256;
    LAS unsigned char* XC = F.lds;
    {
        const LAS float* CW = (const LAS float*)(F.lds + L_CW); const LAS float* CB = (const LAS float*)(F.lds + L_CB);
        const int cc = (tid & 31) * 8, s0 = 4 * (tid >> 5);
        f32x4 wv[4][2], bv[2];
#pragma unroll
        for (int k = 0; k < 4; ++k) { wv[k][0] = *(const LAS f32x4*)(CW + k * 1024 + ch0 + cc); wv[k][1] = *(const LAS f32x4*)(CW + k * 1024 + ch0 + cc + 4); }
        bv[0] = *(const LAS f32x4*)(CB + ch0 + cc); bv[1] = *(const LAS f32x4*)(CB + ch0 + cc + 4);
#pragma unroll
        for (int e = 0; e < 4; ++e) {
            float acc[8];
#pragma unroll
            for (int q = 0; q < 4; ++q) { acc[q] = bv[0][q]; acc[4 + q] = bv[1][q]; }
#pragma unroll
            for (int k = 0; k < 4; ++k) { const u32x4 raw = p.raw[e + k];
                acc[0] += wv[k][0][0] * bflo(raw.x); acc[1] += wv[k][0][1] * bfhi(raw.x); acc[2] += wv[k][0][2] * bflo(raw.y); acc[3] += wv[k][0][3] * bfhi(raw.y);
                acc[4] += wv[k][1][0] * bflo(raw.z); acc[5] += wv[k][1][1] * bfhi(raw.z); acc[6] += wv[k][1][2] * bflo(raw.w); acc[7] += wv[k][1][3] * bfhi(raw.w); }
            u32x4 o; o.x = pk2(acc[0], acc[1]); o.y = pk2(acc[2], acc[3]); o.z = pk2(acc[4], acc[5]); o.w = pk2(acc[6], acc[7]);
            *(LAS u32x4*)(XC + (s0 + e) * LX_PITCH + cc * 2) = o; }
    }
    __syncthreads();
    {
        const int w = F.wave, bl = w >> 1, nt = w & 1, ql = lane & 31, h = lane >> 5;
        f32x16 ga[2], gx[2];
#pragma unroll
        for (int i = 0; i < 16; ++i) { ga[0][i] = p.ba; ga[1][i] = p.ba; gx[0][i] = p.bx; gx[1][i] = p.bx; }
#pragma unroll
        for (int kk = 0; kk < 4; ++kk) {
#pragma unroll
            for (int mt = 0; mt < 2; ++mt) { const bf16x8 xa = *(const LAS bf16x8*)(XC + (32 * mt + ql) * LX_PITCH + (bl * 64 + 16 * kk + 8 * h) * 2);
                ga[mt] = MFMA32(xa, p.wa[kk], ga[mt]); gx[mt] = MFMA32(xa, p.wx[kk], gx[mt]); }
        }
        const int chl = bl * 64 + 32 * nt + ql, chg = ch0 + chl;
        const float sp8 = -8.0f * __builtin_amdgcn_logf(1.0f + __builtin_amdgcn_exp2f(-LOG2E * p.lam));
#pragma unroll
        for (int mt = 0; mt < 2; ++mt)
#pragma unroll
            for (int i = 0; i < 16; ++i) { const int tok = 32 * mt + crow(i, h);
                const float r = __builtin_amdgcn_rcpf(1.0f + __builtin_amdgcn_exp2f(ga[mt][i])), ig = __builtin_amdgcn_rcpf(1.0f + __builtin_amdgcn_exp2f(gx[mt][i])), av = __builtin_amdgcn_exp2f(r * sp8);
                const float xc = bf2f(*(const LAS bf16_t*)(XC + tok * LX_PITCH + chl * 2));
                ga[mt][i] = av; gx[mt][i] = __builtin_amdgcn_sqrtf(1.0f - av * av) * (ig * xc); }
        float gA[8], gH[8], pA[8], pH[8], cin[8], ain[8];
#pragma unroll
        for (int k = 0; k < 8; ++k) { float A = 1.f, H = 0.f;
#pragma unroll
            for (int e = 0; e < 4; ++e) { const float av = ga[k >> 2][4 * (k & 3) + e], uv = gx[k >> 2][4 * (k & 3) + e]; H = av * H + uv; A *= av; }
            gA[k] = A; gH[k] = H; }
#pragma unroll
        for (int k = 0; k < 8; ++k) { pA[k] = shx(gA[k], lane, 32); pH[k] = shx(gH[k], lane, 32); }
        const size_t cidx = ((size_t)b * 128 + c) * 1024 + chg;
        float st = 0.f, At = 1.f;
#pragma unroll
        for (int k = 0; k < 8; ++k) {
            const float A0 = h == 0 ? gA[k] : pA[k], H0 = h == 0 ? gH[k] : pH[k], A1 = h == 0 ? pA[k] : gA[k], H1 = h == 0 ? pH[k] : gH[k];
            const float s0 = st; st = A0 * st + H0; const float s1 = st; st = A1 * st + H1;
            cin[k] = h == 0 ? s0 : s1; ain[k] = h == 0 ? At : At * A0; At *= A0 * A1; }
        if (h == 0 && !dry) { __hip_atomic_store((float*)(F.ws + WS_LA) + cidx, At, __ATOMIC_RELAXED, __HIP_MEMORY_SCOPE_AGENT); __hip_atomic_store((float*)(F.ws + WS_LH) + cidx, st, __ATOMIC_RELAXED, __HIP_MEMORY_SCOPE_AGENT); }
        LAS unsigned char* YS = F.lds + L_YST + chl * 2; LAS unsigned char* AS = F.lds + L_AST + chl;
#pragma unroll
        for (int k = 0; k < 8; ++k) { float sv = cin[k], ac = ain[k];
#pragma unroll
            for (int e = 0; e < 4; ++e) { const int i = 4 * (k & 3) + e; const float av = ga[k >> 2][i]; sv = av * sv + gx[k >> 2][i]; ac *= av;
                const int tok = 32 * (k >> 2) + crow(i, h);
                *(LAS bf16_t*)(YS + tok * LX_PITCH) = f2bf(sv); *(LAS unsigned char*)(AS + tok * L_AP) = (unsigned char)(int)(ac * 255.0f + 0.5f); } }
    }
    __syncthreads();
    if (!dry) {
        bf16_t* YA = (bf16_t*)(F.ws + WS_YA) + ((size_t)b * 8192 + c * 64) * 1024 + ch0;
        unsigned char* AC = (unsigned char*)(F.ws + WS_ACUM) + ((size_t)b * 8192 + c * 64) * 1024 + ch0;
#pragma unroll
        for (int i = 0; i < 4; ++i) { const int pc = tid + NTHR * i, row = pc >> 5, c16 = pc & 31;
            __builtin_nontemporal_store(*(const LAS u32x4*)(F.lds + L_YST + row * LX_PITCH + c16 * 16), (u32x4*)(YA + (size_t)row * 1024 + c16 * 8)); }
#pragma unroll
        for (int i = 0; i < 2; ++i) { const int pc = tid + NTHR * i, row = pc >> 4, c16 = pc & 15;
            __builtin_nontemporal_store(*(const LAS u32x4*)(F.lds + L_AST + row * L_AP + c16 * 16), (u32x4*)(AC + (size_t)row * 1024 + c16 * 16)); }
    }
}
template <bool FINAL> DI void lru_units(const Frame& F, const Args& a, int l, bool dry = false) {
    if (F.vcu >= 1024) return;
    { const int lane = lane_id(); lru_stage_conv(F, a, l, F.wave * 64 + lane); }
    LruPre cur;
    lru_issue<FINAL>(cur, F.vcu, F, a, l, lane_id());
    int par = 0;
    for (int u = F.vcu; u < 1024; u += F.G) {
        LruPre nxt; const bool hn = u + F.G < 1024; const int lane = lane_id();
        if (hn) lru_issue<FINAL>(nxt, u + F.G, F, a, l, lane); else nxt = cur;
        lru_compute<FINAL>(cur, u, F, lane, dry, par); par ^= 1;
        cur = nxt;
    }
    __syncthreads();
}
DI float shup(float v, int lane, int d) { return __int_as_float(__builtin_amdgcn_ds_bpermute((lane - d) << 2, __float_as_int(v))); }
DI void lru2_unit(int u, const Frame& F) {
    FRAME_LT;
    const int seq = u * 8 + F.wave, ch = seq & 1023, b = seq >> 10;
    const float* LA = (const float*)(F.ws + WS_LA) + (size_t)b * 128 * 1024 + ch; const float* LH = (const float*)(F.ws + WS_LH) + (size_t)b * 128 * 1024 + ch;
    float* LC = (float*)(F.ws + WS_LC) + (size_t)b * 128 * 1024 + ch;
    const float a0 = LA[(size_t)(2 * lane) * 1024], h0 = LH[(size_t)(2 * lane) * 1024], a1 = LA[(size_t)(2 * lane + 1) * 1024], h1 = LH[(size_t)(2 * lane + 1) * 1024];
    float A = a0 * a1, H = a1 * h0 + h1;
#pragma unroll
    for (int d = 1; d < 64; d <<= 1) { const float Ap = shup(A, lane, d), Hp = shup(H, lane, d); if (lane >= d) { H = A * Hp + H; A = A * Ap; } }
    float E = shup(H, lane, 1); if (lane == 0) E = 0.f;
    __hip_atomic_store(LC + (size_t)(2 * lane) * 1024, E, __ATOMIC_RELAXED, __HIP_MEMORY_SCOPE_AGENT); __hip_atomic_store(LC + (size_t)(2 * lane + 1) * 1024, a0 * E + h0, __ATOMIC_RELAXED, __HIP_MEMORY_SCOPE_AGENT);
}

constexpr int N_PHASES = 17;
__global__ void __launch_bounds__(NTHR, 2) hybrid_fwd(Args args) {
    extern __shared__ __attribute__((aligned(16))) unsigned char lds_raw[];
    Frame F;
    F.lds = (LAS unsigned char*)lds_raw;
    const int wave_s = __builtin_amdgcn_readfirstlane((int)threadIdx.x >> 6);
    F.wave = wave_s;
    F.G = gridDim.x; { const int bx = blockIdx.x; F.vcu = (F.G % 8 == 0) ? (bx % 8) * (F.G / 8) + bx / 8 : bx; }
    F.ws = (GAS unsigned char*)args.ws;
    volatile LAS unsigned* MISC = (volatile LAS unsigned*)(F.lds + MISC_OFF);
    { const int tid0 = wave_s * 64 + lane_id();
      for (int u = tid0; u < (LDS_BYTES - LDSCTL_OFF) / 4; u += NTHR) ((LAS unsigned*)(F.lds + LDSCTL_OFF))[u] = 0u; }
    __syncthreads();
    XcdBarrier bar; bar.bar = (unsigned*)(F.ws + WS_CTL); bar.x = 0; bar.st = nullptr;
#if !MK_SPLIT
    bar = xcd_barrier_post((unsigned*)(F.ws + WS_CTL), MISC + 8, wave_s * 64 + lane_id());
#endif
    int lo = args.ph_lo; const int hi = args.ph_hi;
#ifndef PHMASK
#define PHMASK 0x1ff
#endif
    if (lo == 0) {
        if (PHMASK & 1) phase_pre(F, args);
        lo = 1;
#if !MK_SPLIT
        if (F.G == 256) ctr_arrive((unsigned*)(F.ws + WS_CTL), CS_PRE, wave_s * 64 + lane_id());
        else if (lo < hi) xcd_barrier(bar, wave_s * 64 + lane_id());
#endif
    }
    for (int ph = lo; ph < hi; ++ph) {
        int bx = blockIdx.x; asm volatile("" : "+s"(bx));
        { GAS unsigned char* wsl = (GAS unsigned char*)args.ws; asm volatile("" : "+s"(wsl)); F.ws = wsl; }
        {
            const int l = (ph - 1) >> 3, sub = (ph - 1) & 7;
            if (!((PHMASK >> (sub + 1)) & 1)) {}
            else if (sub == 0) {
                if (!MK_SPLIT && F.G == 256) {
                    if (l == 0) phase_norm(F, args, l, 0);
                    else {
                        phase_norm(F, args, l, 0, false, 1);
                        xcd_barrier_wait(bar, wave_s * 64 + lane_id());
                        phase_norm(F, args, l, 0, false, 2); }
                    xcd_barrier_arrive(bar, wave_s * 64 + lane_id());
                    if (l == 0) ctr_wait((unsigned*)(F.ws + WS_CTL), CS_PRE, 256u, wave_s * 64 + lane_id());
                    phase_norm(F, args, l, 1, true);
                    xcd_barrier_wait(bar, wave_s * 64 + lane_id());
                    group_barrier((unsigned*)(F.ws + WS_CTL), CS_NORM + l * 64 + 8 * (bx & 7) + ((bx >> 3) & 7), 4u, wave_s * 64 + lane_id());
                } else { phase_norm(F, args, l); if (REP == 1) { __syncthreads(); phase_norm(F, args, l); } }
            }
            else if (sub == 1 || sub == 5) {
                pg8::APlain ap{(const bf16_t*)(F.ws + WS_H), 1024};
                if (sub == 1) {
                    const int tid = wave_s * 64 + lane_id();
                    pg8::StaticOrder S; S.init(T, N_G1A, F.G, bx);
                    const bool ho = !MK_SPLIT && F.G == 256;
                    EpiG1<0> E{false, F.ws, ARGIN(args, 14) + (size_t)l * 192, ARGIN(args, 15) + (size_t)l * 192, ho ? (unsigned*)(F.ws + WS_CTL) + GB_BASE + 16 * (CS_AX + l) : nullptr};
                    pg8::gemm_phase<EpiG1<0>, pg8::APlain, pg8::StaticOrder>(F.lds, tid, ap, (const bf16_t*)(F.ws + WS_WIN), 1024, 1024, S, E);
                    if (REP == 2) pg8::gemm_phase<EpiG1<0>, pg8::APlain, pg8::StaticOrder>(F.lds, tid, ap, (const bf16_t*)(F.ws + WS_WIN), 1024, 1024, S, E);
                    if (ho) ctr_arrive((unsigned*)(F.ws + WS_CTL), CS_G1A + l, wave_s * 64 + lane_id());
                } else {
                    const int tid = wave_s * 64 + lane_id();
                    if (!MK_SPLIT && F.G == 256) ctr_wait((unsigned*)(F.ws + WS_CTL), CS_MIX2 + l, 256u, tid);
                    pg8::StaticOrder S; S.init(T, N_G1B, F.G, bx);
                    EpiG1<1> E{false, F.ws, nullptr, nullptr};
                    pg8::gemm_phase<EpiG1<1>, pg8::APlain, pg8::StaticOrder>(F.lds, tid, ap, (const bf16_t*)(F.ws + WS_WIN) + (size_t)N_G1A * 1024, 1024, 1024, S, E);
                    if (REP == 16) { EpiG1<1> ED{true, F.ws, nullptr, nullptr}; pg8::gemm_phase<EpiG1<1>, pg8::APlain, pg8::StaticOrder>(F.lds, wave_s * 64 + lane_id(), ap, (const bf16_t*)(F.ws + WS_WIN) + (size_t)N_G1A * 1024, 1024, 1024, S, ED); }
                    if (REP == 10) { EpiNull EN; pg8::gemm_phase<EpiNull, pg8::APlain, pg8::StaticOrder>(F.lds, wave_s * 64 + lane_id(), ap, (const bf16_t*)(F.ws + WS_WIN) + (size_t)N_G1A * 1024, 1024, 1024, S, EN); }
                }
            }
            else if (sub == 2) {
                const bool ho = !MK_SPLIT && F.G == 256;
                if (ho) ctr_wait((unsigned*)(F.ws + WS_CTL), CS_AX + l, 256u, wave_s * 64 + lane_id());
                lru_units<false>(F, args, l); if (REP == 3) lru_units<false>(F, args, l);
                if (ho) ctr_arrive((unsigned*)(F.ws + WS_CTL), CS_LRU + l, wave_s * 64 + lane_id());
                if (ho) ctr_wait((unsigned*)(F.ws + WS_CTL), CS_G1A + l, 256u, wave_s * 64 + lane_id());
                gla1_units(F, args, l); if (REP == 4) gla1_units(F, args, l);
                if (ho) ctr_arrive((unsigned*)(F.ws + WS_CTL), CS_GLA1 + l, wave_s * 64 + lane_id());
                if (REP == 7) { int dry = 1; asm volatile("" : "+s"(dry)); att_units(F, dry != 0); }
                att_units(F);
                if (ho) xcd_barrier_arrive(bar, wave_s * 64 + lane_id());
            }
            else if (sub == 3) {
                const bool ho = !MK_SPLIT && F.G == 256;
                if (ho) {
                    ctr_wait((unsigned*)(F.ws + WS_CTL), CS_GLA1 + l, 256u, wave_s * 64 + lane_id());
                    gla2_unit(F.vcu, F);
                    ctr_arrive((unsigned*)(F.ws + WS_CTL), CS_GLA2 + l * 8 + (F.vcu >> 5), wave_s * 64 + lane_id());
                    ctr_wait((unsigned*)(F.ws + WS_CTL), CS_LRU + l, 256u, wave_s * 64 + lane_id());
                    lru2_unit(F.vcu, F);
                    xcd_barrier_wait(bar, wave_s * 64 + lane_id());
                    yb_unit(F.vcu, F);
                    ctr_arrive((unsigned*)(F.ws + WS_CTL), CS_MIX2 + l, wave_s * 64 + lane_id());
                } else
                for (int u = F.vcu; u < 256 + 256 + 256; u += F.G) {
                    if (u < 256) { if (REP == 13) { int dry = 1; asm volatile("" : "+s"(dry)); gla2_unit(u, F, dry != 0); } gla2_unit(u, F); }
                    else if (u < 512) { yb_unit(u - 256, F); if (REP == 9) yb_unit(u - 256, F); } else lru2_unit(u - 512, F); }
            }
            else if (sub == 4) {
                if (!MK_SPLIT && F.G == 256) {
                    const int x = F.vcu >> 5, j = F.vcu & 31, pm = 8 * x + (j & 7);
                    ctr_wait((unsigned*)(F.ws + WS_CTL), CS_GLA2 + l * 8 + (pm >> 5) * 4 + (j >> 3), 32u, wave_s * 64 + lane_id()); }
                if (REP == 8) { int dry = 1; asm volatile("" : "+s"(dry)); gla3_units(F, args, l, dry != 0); }
                gla3_units(F, args, l);
            }
            else if (sub == 6) {
                const int tid = wave_s * 64 + lane_id();
                pg8::ASeg3 ap{(const bf16_t*)(F.ws + WS_YA), (const bf16_t*)(F.ws + WS_YB), (const bf16_t*)(F.ws + WS_YC), 1024};
                pg8::StaticOrder S; S.init(T, 1024, F.G, bx);
                EpiG2 E{F.ws};
                pg8::gemm_phase<EpiG2, pg8::ASeg3, pg8::StaticOrder>(F.lds, tid, ap, (const bf16_t*)(F.ws + WS_WP), 2560, 2560, S, E);
                if (REP == 15) pg8::gemm_phase<EpiG2, pg8::ASeg3, pg8::StaticOrder>(F.lds, wave_s * 64 + lane_id(), ap, (const bf16_t*)(F.ws + WS_WP), 2560, 2560, S, E);
                if (REP == 6) { EpiNull EN; pg8::gemm_phase<EpiNull, pg8::ASeg3, pg8::StaticOrder>(F.lds, wave_s * 64 + lane_id(), ap, (const bf16_t*)(F.ws + WS_WP), 2560, 2560, S, EN); }
            }
            else {
                const int tid = wave_s * 64 + lane_id();
                pg8::ABlk ap{(const bf16_t*)(F.ws + WS_MERGED), 4, 256};
                pg8::StaticOrder S; S.init(T, 1024, F.G, bx);
                EpiG3 E{l == 0 ? ARGIN(args, 0) : (const float*)ARGOUT(args), ARGOUT(args), (const float*)(F.ws + WS_MODF) + (size_t)l * 2 * 3072 + 2048, l == 1};
                pg8::gemm_phase<EpiG3, pg8::ABlk, pg8::StaticOrder>(F.lds, tid, ap, (const bf16_t*)(F.ws + WS_WO), 1024, 1024, S, E);
                if (REP == 14 && l == 0) pg8::gemm_phase<EpiG3, pg8::ABlk, pg8::StaticOrder>(F.lds, wave_s * 64 + lane_id(), ap, (const bf16_t*)(F.ws + WS_WO), 1024, 1024, S, E);
                if (REP == 12) { EpiNull EN; pg8::gemm_phase<EpiNull, pg8::ABlk, pg8::StaticOrder>(F.lds, wave_s * 64 + lane_id(), ap, (const bf16_t*)(F.ws + WS_WO), 1024, 1024, S, EN); }
            }
        }
#if !MK_SPLIT
        if (ph + 1 < hi) {
            const int sub_ = (ph - 1) & 7, l_ = (ph - 1) >> 3;
            if (F.G == 256 && sub_ <= 3) {}
            else if (F.G == 256 && sub_ >= 4 && sub_ <= 6)
                group_barrier((unsigned*)(F.ws + WS_CTL), (l_ * 3 + (sub_ - 4)) * 64 + 8 * (bx & 7) + ((bx >> 3) & 7), 4u, wave_s * 64 + lane_id());
            else if (F.G == 256 && sub_ == 7) xcd_barrier_arrive(bar, wave_s * 64 + lane_id());
            else { xcd_barrier(bar, wave_s * 64 + lane_id()); if (REP == 11) xcd_barrier(bar, wave_s * 64 + lane_id()); }
        }
#endif
    }
}

extern "C" void kernel_launch(void* const* d_in, const int* in_sizes, int n_in, void* d_out, int out_size, void* d_ws, size_t ws_size, hipStream_t stream) {
    static int grid = 0;
    if (grid == 0) {
        if (n_in != 24 || out_size != T * DM || ws_size < WS_END) { fprintf(stderr, "kernel_launch: unexpected shapes (n_in %d, out %d, ws %zu < %zu)\n", n_in, out_size, ws_size, (size_t)WS_END); grid = -1; return; }
        int dev = 0, cus = 0, per_cu = 0;
        if (hipGetDevice(&dev) != hipSuccess || hipDeviceGetAttribute(&cus, hipDeviceAttributeMultiprocessorCount, dev) != hipSuccess) { grid = -1; return; }
        if (hipFuncSetAttribute((const void*)hybrid_fwd, hipFuncAttributeMaxDynamicSharedMemorySize, LDS_BYTES) != hipSuccess) { fprintf(stderr, "kernel_launch: hipFuncSetAttribute failed\n"); grid = -1; return; }
        if (hipOccupancyMaxActiveBlocksPerMultiprocessor(&per_cu, (const void*)hybrid_fwd, NTHR, LDS_BYTES) != hipSuccess || per_cu < 1) { fprintf(stderr, "kernel_launch: occupancy query says %d blocks/CU\n", per_cu); (void)hipGetLastError(); }
        grid = cus;
    }
    if (grid < 0) return;
    (void)hipMemsetAsync((char*)d_ws + WS_CTL, 0, CTL_ZERO_BYTES, stream);
    Args a{};
    for (int i = 0; i < 24; ++i) a.in[i] = (const float*)d_in[i];
    a.out = (float*)d_out; a.ws = (unsigned char*)d_ws;
#if MK_SPLIT
    for (int ph = 0; ph < N_PHASES; ++ph) { a.ph_lo = ph; a.ph_hi = ph + 1; hipLaunchKernelGGL(hybrid_fwd, dim3(grid), dim3(NTHR), LDS_BYTES, stream, a); }
#else
    a.ph_lo = 0; a.ph_hi = N_PHASES;
    hipLaunchKernelGGL(hybrid_fwd, dim3(grid), dim3(NTHR), LDS_BYTES, stream, a);
#endif
}
```
